# Optimizing an MI355X kernel written in HIP

```python
import math
import jax, jax.numpy as jnp
from jax import lax
import numpy as np

D_MODEL = 1024
BATCH = 8
SEQ = 2048
DEPTH = 4

GRID_W = 64
CTX_LEN = 256
N_MIXERS = 2
BRANCH = D_MODEL
GLA_HEADS = 4
GLA_DK = D_MODEL // 2 // GLA_HEADS
GLA_DV = BRANCH // GLA_HEADS
GLA_KEY_W = GLA_HEADS * GLA_DK
GLA_GATE_RANK = 16
GLA_TAU = 16.0
GLA_CHUNK = 64
NA_HEADS = 16
NA_DH = BRANCH // NA_HEADS
NA_KH = 8
NA_KW = 16
ROPE_BASE = 10000.0
LN_EPS = 1e-5
NORM_EPS = 1e-6
ALPHA = (2 * DEPTH) ** 0.25
BETA = (8 * DEPTH) ** -0.25
N_GLA_LAYERS = (DEPTH + 1) // N_MIXERS
N_NA_LAYERS = DEPTH // N_MIXERS

kernel_name = 'hybrid_gla_natten_prefix_dit'


def layer_norm(x, g, b):
    xf = x.astype(jnp.float32)
    mu = jnp.mean(xf, -1, keepdims=True)
    var = jnp.mean(jnp.square(xf - mu), -1, keepdims=True)
    y = (xf - mu) * lax.rsqrt(var + LN_EPS)
    return (y * g + b).astype(x.dtype)


def adaln(cond, w, b):
    m = jax.nn.silu(cond) @ w + b
    return jnp.split(m, 3, axis=-1)


def to_heads(t, n_heads):
    B, L, _ = t.shape
    return t.reshape(B, L, n_heads, -1).transpose(0, 2, 1, 3)


def from_heads(t):
    B, H, L, d = t.shape
    return t.transpose(0, 2, 1, 3).reshape(B, L, H * d)


def axial_rope_tables(n_tokens, dim):
    pos = jnp.arange(n_tokens, dtype=jnp.int32)
    row = (pos // GRID_W).astype(jnp.float32)
    col = (pos % GRID_W).astype(jnp.float32)
    quarter = dim // 4
    inv = ROPE_BASE ** (-jnp.arange(quarter, dtype=jnp.float32) / quarter)
    ang = jnp.concatenate([row[:, None] * inv, col[:, None] * inv], -1)
    return jnp.cos(ang), jnp.sin(ang)


def apply_rope(x, cos, sin):
    x1, x2 = jnp.split(x, 2, axis=-1)
    cos = cos.astype(x.dtype)
    sin = sin.astype(x.dtype)
    return jnp.concatenate([x1 * cos - x2 * sin, x1 * sin + x2 * cos], -1)


def gla_chunked(q, k, v, log_a, s0, strict):
    B, H, L, dk = q.shape
    dv = v.shape[-1]
    C = GLA_CHUNK
    n = L // C
    qc = q.reshape(B, H, n, C, dk)
    kc = k.reshape(B, H, n, C, dk)
    vc = v.reshape(B, H, n, C, dv)
    la = log_a.astype(jnp.float32).reshape(B, H, n, C, dk)
    b = jnp.cumsum(la, axis=3)
    b_last = b[:, :, :, -1:, :]
    qb = b - la if strict else b
    q_t = qc * jnp.exp(qb).astype(q.dtype)
    k_t = kc * jnp.exp(-b).astype(q.dtype)
    idx = jnp.arange(C)
    mask = (idx[None, :] < idx[:, None]) if strict else (idx[None, :] <= idx[:, None])
    att = jnp.where(mask, jnp.einsum('bhnqd,bhnsd->bhnqs', q_t, k_t), 0)
    o_intra = jnp.einsum('bhnqs,bhnse->bhnqe', att, vc)
    k_end = kc * jnp.exp(b_last - b).astype(q.dtype)
    kv = jnp.einsum('bhnsd,bhnse->bhnde', k_end, vc)
    dec = jnp.exp(b_last[:, :, :, 0, :])

    def step(s, inp):
        d_n, kv_n = inp
        return d_n[..., None] * s + kv_n, s

    s_fin, s_prev = lax.scan(step, s0, (jnp.moveaxis(dec, 2, 0), jnp.moveaxis(kv, 2, 0)))
    s_prev = jnp.moveaxis(s_prev, 0, 2)
    o_inter = jnp.einsum('bhnqd,bhnde->bhnqe', q_t, s_prev)
    o = (o_intra + o_inter).reshape(B, H, L, dv).astype(v.dtype)
    return o, s_fin


def gla_bidir(q, k, v, la_f, la_b, s0_f, s0_b):
    o_f, s_f = gla_chunked(q, k, v, la_f, s0_f, strict=False)
    flip = lambda t: jnp.flip(t, axis=2)
    o_b, s_b = gla_chunked(flip(q), flip(k), flip(v), flip(la_b), s0_b, strict=True)
    return o_f + flip(o_b), s_f, s_b


def gla_project(h, w_in, dec_w1, dec_w2, dec_b, rope):
    p = h @ w_in
    q, k, v, g = jnp.split(p, [GLA_KEY_W, 2 * GLA_KEY_W, 2 * GLA_KEY_W + BRANCH], axis=-1)
    q = to_heads(q, GLA_HEADS) * GLA_DK ** -0.5
    k = to_heads(k, GLA_HEADS)
    if rope is not None:
        cos, sin = rope
        q = apply_rope(q, cos, sin)
        k = apply_rope(k, cos, sin)
    v = to_heads(v, GLA_HEADS)
    low = jnp.einsum('bld,zdr->zblr', h, dec_w1)
    logits = jnp.einsum('zblr,zrk->zblk', low, dec_w2) + dec_b[:, None, None, :]
    log_a = jax.nn.log_sigmoid(logits.astype(jnp.float32)) / GLA_TAU
    return q, k, v, to_heads(log_a[0], GLA_HEADS), to_heads(log_a[1], GLA_HEADS), g


def gla_merge(o, g, norm_g, w_out):
    of = o.astype(jnp.float32)
    of = of * lax.rsqrt(jnp.mean(of * of, -1, keepdims=True) + NORM_EPS) * norm_g
    of = from_heads(of).astype(g.dtype)
    return (of * jax.nn.silu(g)) @ w_out


def gla_layer(h_lat, h_ctx, w_in, dec_w1, dec_w2, dec_b, norm_g, w_out, rope, need_ctx):
    qc, kc, vc, lfc, lbc, gc = gla_project(h_ctx, w_in, dec_w1, dec_w2, dec_b, None)
    ql, kl, vl, lfl, lbl, gl = gla_project(h_lat, w_in, dec_w1, dec_w2, dec_b, rope)
    s0 = jnp.zeros((h_lat.shape[0], GLA_HEADS, GLA_DK, GLA_DV), jnp.float32)
    o_c, s_f, s_b = gla_bidir(qc, kc, vc, lfc, lbc, s0, s0)
    o_l, _, _ = gla_bidir(ql, kl, vl, lfl, lbl, s_f, s_b)
    y_lat = gla_merge(o_l, gl, norm_g, w_out)
    y_ctx = gla_merge(o_c, gc, norm_g, w_out) if need_ctx else None
    return y_lat, y_ctx


def na_latent(q, k, v, kc, vc, rpb):
    B, H, S, dh = q.shape
    rows = S // GRID_W
    kh = min(NA_KH, rows)
    kw = NA_KW
    col = jnp.arange(GRID_W)
    col_start = jnp.clip(col - kw // 2, 0, GRID_W - kw)
    key_col = col_start[:, None] + jnp.arange(kw)[None, :]
    band_idx = (jnp.arange(kh)[None, :, None] * GRID_W + key_col[:, None, :]).reshape(GRID_W, kh * kw)
    col_off = key_col - col[:, None] + (NA_KW - 1)
    q_rows = jnp.moveaxis(q.reshape(B, H, rows, GRID_W, dh), 2, 0)

    def one_row(inp):
        r, q_r = inp
        r_start = jnp.clip(r - kh // 2, 0, rows - kh)
        k_band = lax.dynamic_slice_in_dim(k, r_start * GRID_W, kh * GRID_W, axis=2)
        v_band = lax.dynamic_slice_in_dim(v, r_start * GRID_W, kh * GRID_W, axis=2)
        k_g = k_band[:, :, band_idx]
        v_g = v_band[:, :, band_idx]
        row_off = r_start + jnp.arange(kh) - r + (NA_KH - 1)
        bias = rpb[:, row_off[None, :, None], col_off[:, None, :]].reshape(H, GRID_W, kh * kw)
        s_loc = jnp.einsum('bhqd,bhqkd->bhqk', q_r, k_g) + bias
        s_ctx = jnp.einsum('bhqd,bhcd->bhqc', q_r, kc)
        p = jax.nn.softmax(jnp.concatenate([s_loc, s_ctx], -1).astype(jnp.float32), axis=-1).astype(v.dtype)
        return (jnp.einsum('bhqk,bhqkd->bhqd', p[..., :kh * kw], v_g)
                + jnp.einsum('bhqc,bhcd->bhqd', p[..., kh * kw:], vc))

    o = lax.map(one_row, (jnp.arange(rows), q_rows))
    return jnp.moveaxis(o, 0, 2).reshape(B, H, S, dh)


def na_merge(o, g, w_out):
    return (from_heads(o) * jax.nn.silu(g)) @ w_out


def na_layer(h_lat, h_ctx, w_in, rpb, w_out, need_ctx):
    q, k, v, g = jnp.split(h_lat @ w_in, 4, axis=-1)
    q = to_heads(q, NA_HEADS) * NA_DH ** -0.5
    k = to_heads(k, NA_HEADS)
    v = to_heads(v, NA_HEADS)
    if need_ctx:
        qc, kc, vc, gc = jnp.split(h_ctx @ w_in, 4, axis=-1)
    else:
        kc, vc = jnp.split(h_ctx @ w_in[:, BRANCH:3 * BRANCH], 2, axis=-1)
    kc = to_heads(kc, NA_HEADS)
    vc = to_heads(vc, NA_HEADS)
    y_lat = na_merge(na_latent(q, k, v, kc, vc, rpb), g, w_out)
    y_ctx = None
    if need_ctx:
        qc = to_heads(qc, NA_HEADS) * NA_DH ** -0.5
        p = jax.nn.softmax(jnp.einsum('bhqd,bhkd->bhqk', qc, kc).astype(jnp.float32), axis=-1).astype(vc.dtype)
        y_ctx = na_merge(jnp.einsum('bhqk,bhkd->bhqd', p, vc), gc, w_out)
    return y_lat, y_ctx


def setup_inputs(seed: int = 0) -> dict:
    key = jax.random.key(seed)
    ks = jax.random.split(key, 17)
    nrm = lambda k, shape, s: jax.random.normal(k, shape, jnp.float32) * s
    D = D_MODEL
    return {
        'x': nrm(ks[0], (BATCH, SEQ, D), 1.0),
        'c': nrm(ks[1], (BATCH, D), 1.0),
        'ctx': nrm(ks[2], (BATCH, CTX_LEN, D), 1.0),
        'c_ctx': nrm(ks[3], (D,), 1.0),
        'ada_w': nrm(ks[4], (DEPTH, D, 3 * D), 0.5 * D ** -0.5),
        'ada_b': nrm(ks[5], (DEPTH, 3 * D), 0.02),
        'ln_g': 1.0 + nrm(ks[6], (DEPTH, D), 0.02),
        'ln_b': nrm(ks[7], (DEPTH, D), 0.02),
        'w_out': nrm(ks[8], (DEPTH, BRANCH, D), BETA * BRANCH ** -0.5),
        'gla_w_in': nrm(ks[9], (N_GLA_LAYERS, D, 2 * GLA_KEY_W + 2 * BRANCH), D ** -0.5),
        'gla_dec_w1': nrm(ks[10], (N_GLA_LAYERS, 2, D, GLA_GATE_RANK), D ** -0.5),
        'gla_dec_w2': nrm(ks[11], (N_GLA_LAYERS, 2, GLA_GATE_RANK, GLA_KEY_W), GLA_GATE_RANK ** -0.5),
        'gla_dec_b': nrm(ks[12], (N_GLA_LAYERS, 2, GLA_KEY_W), 0.1),
        'gla_norm_g': 1.0 + nrm(ks[13], (N_GLA_LAYERS, GLA_DV), 0.02),
        'na_w_in': nrm(ks[14], (N_NA_LAYERS, D, 4 * BRANCH), D ** -0.5),
        'na_rpb': nrm(ks[15], (N_NA_LAYERS, NA_HEADS, 2 * NA_KH - 1, 2 * NA_KW - 1), 0.1),
    }


def reference(x, c, ctx, c_ctx, ada_w, ada_b, ln_g, ln_b, w_out, gla_w_in, gla_dec_w1,
              gla_dec_w2, gla_dec_b, gla_norm_g, na_w_in, na_rpb):
    S = x.shape[1]
    rope = axial_rope_tables(S, GLA_DK)
    cond_lat = c[:, None, :]
    cond_ctx = c_ctx[None, None, :]
    for i in range(DEPTH):
        need_ctx = i < DEPTH - 1
        j = i // N_MIXERS
        sh_l, sc_l, gt_l = adaln(cond_lat, ada_w[i], ada_b[i])
        sh_c, sc_c, gt_c = adaln(cond_ctx, ada_w[i], ada_b[i])
        h_lat = x * (1 + sc_l) + sh_l
        h_ctx = ctx * (1 + sc_c) + sh_c
        if i % N_MIXERS == 0:
            y_lat, y_ctx = gla_layer(h_lat, h_ctx, gla_w_in[j], gla_dec_w1[j], gla_dec_w2[j],
                                     gla_dec_b[j], gla_norm_g[j], w_out[i], rope, need_ctx)
        else:
            y_lat, y_ctx = na_layer(h_lat, h_ctx, na_w_in[j], na_rpb[j], w_out[i], need_ctx)
        x = layer_norm(ALPHA * x + gt_l * y_lat, ln_g[i], ln_b[i])
        if need_ctx:
            ctx = layer_norm(ALPHA * ctx + gt_c * y_ctx, ln_g[i], ln_b[i])
    return x
```

```cpp
#include <hip/hip_runtime.h>
#include <hip/hip_cooperative_groups.h>
namespace cg = cooperative_groups;

#define REP_GIN 1
#define REP_GOUT 1
#define REP_PREP 1
#define REP_CHAIN 1
#define REP_NA 1
#ifndef MULTI_LAUNCH
#define MULTI_LAUNCH 0
#endif

#define DI __device__ __forceinline__
typedef short bf16x8 __attribute__((ext_vector_type(8)));
typedef float f32x4 __attribute__((ext_vector_type(4)));
typedef float f32x2 __attribute__((ext_vector_type(2)));
typedef unsigned u32x4 __attribute__((ext_vector_type(4)));
typedef unsigned u32x2 __attribute__((ext_vector_type(2)));
typedef __bf16 bf2 __attribute__((ext_vector_type(2)));
typedef unsigned short u16;

DI unsigned pk2(float lo, float hi) { f32x2 v = {lo, hi}; bf2 b = __builtin_convertvector(v, bf2); return __builtin_bit_cast(unsigned, b); }
DI float bf_lo(unsigned u) { return __uint_as_float(u << 16); }
DI float bf_hi(unsigned u) { return __uint_as_float(u & 0xffff0000u); }
DI float bf2f(u16 h) { return __uint_as_float(((unsigned)h) << 16); }
DI u16 f2bf(float f) { return (u16)(pk2(f, 0.f) & 0xffffu); }
DI f32x4 mfma16(bf16x8 a, bf16x8 b, f32x4 c) { return __builtin_amdgcn_mfma_f32_16x16x32_bf16(a, b, c, 0, 0, 0); }
DI float siluf(float x) { return x * __builtin_amdgcn_rcpf(1.f + __expf(-x)); }

constexpr int D = 1024, NB = 8, SEQ = 2048, CTXL = 256, LSEQ = 2304, MROWS = NB * LSEQ;
constexpr int NCHUNK = 36;
constexpr size_t MiB = 1u << 20;
constexpr size_t U = 36 * MiB;
constexpr size_t OFF_R0 = 0, OFF_R1 = U, OFF_R2 = 2 * U, OFF_R3 = 3 * U, OFF_R4 = 4 * U, OFF_R5 = 5 * U, OFF_R6 = 6 * U;
constexpr size_t OFF_XCTX = 234 * MiB, OFF_WIN = 242 * MiB, OFF_WOUT = 250 * MiB, OFF_LOW = 252 * MiB;
constexpr size_t OFF_DEC = OFF_LOW + (size_t)MROWS * 32 * 2;
constexpr size_t OFF_MOD = OFF_DEC + (size_t)2304 * 128 * 4;
constexpr size_t OFF_ROPE = OFF_MOD + (size_t)4 * 9 * 3072 * 4;
constexpr size_t OFF_BAR = OFF_ROPE + (size_t)2 * 64 * 32 * 4;
constexpr size_t WS_END = OFF_BAR + 3456 * 4;
constexpr float ALPHA = 1.681792830507429f;

struct Ctx { int tid, bid, nblk; };
struct Params {
  const float *x, *c, *ctx, *c_ctx, *ada_w, *ada_b, *ln_g, *ln_b, *w_out, *gla_w_in, *gla_dec_w1, *gla_dec_w2, *gla_dec_b, *gla_norm_g, *na_w_in, *na_rpb;
  float* out; unsigned char* ws; int ph_lo, ph_hi;
};

DI void transpose_tile(const Ctx& cx, const float* __restrict__ src, int N, u16* __restrict__ dst, int k0, int n0, char* smem) {
  float* t = (float*)smem;
  const int tid = cx.tid;
  __syncthreads();
#pragma unroll
  for (int i = 0; i < 4; ++i) {
    int k = (tid >> 4) + 16 * i, n4 = (tid & 15) * 4;
    f32x4 v = *(const f32x4*)(src + (size_t)(k0 + k) * N + n0 + n4);
    t[k * 65 + n4] = v[0]; t[k * 65 + n4 + 1] = v[1]; t[k * 65 + n4 + 2] = v[2]; t[k * 65 + n4 + 3] = v[3];
  }
  __syncthreads();
#pragma unroll
  for (int j = 0; j < 2; ++j) {
    int c = tid + 256 * j, n = c >> 3, kc = (c & 7) * 8;
    u32x4 o;
    o[0] = pk2(t[(kc + 0) * 65 + n], t[(kc + 1) * 65 + n]); o[1] = pk2(t[(kc + 2) * 65 + n], t[(kc + 3) * 65 + n]);
    o[2] = pk2(t[(kc + 4) * 65 + n], t[(kc + 5) * 65 + n]); o[3] = pk2(t[(kc + 6) * 65 + n], t[(kc + 7) * 65 + n]);
    *(u32x4*)(dst + (size_t)(n0 + n) * 1024 + k0 + kc) = o;
  }
}

DI int convert_items(int layer) { return (layer & 1) ? (16 * 64 + 256) : (16 * 48 + 16 + 256); }
DI void convert_item(const Ctx& cx, const Params& p, int layer, int it, char* smem) {
  u16* win = (u16*)(p.ws + OFF_WIN); u16* wout = (u16*)(p.ws + OFF_WOUT);
  const int j = layer >> 1;
  if (layer & 1) {
    if (it < 1024) { transpose_tile(cx, p.na_w_in + (size_t)j * 1024 * 4096, 4096, win, (it >> 6) * 64, (it & 63) * 64, smem); return; }
    it -= 1024;
  } else {
    if (it < 768) { transpose_tile(cx, p.gla_w_in + (size_t)j * 1024 * 3072, 3072, win, (it / 48) * 64, (it % 48) * 64, smem); return; }
    it -= 768;
    if (it < 16) {
      const float* w1 = p.gla_dec_w1 + (size_t)j * 2 * 1024 * 16;
#pragma unroll 4
      for (int idx = cx.tid; idx < 8 * 1024; idx += 256) {
        int row = it * 8 + (idx >> 10), k = idx & 1023;
        float v = row < 32 ? w1[((size_t)(row >> 4) * 1024 + k) * 16 + (row & 15)] : 0.f;
        win[(size_t)(3072 + row) * 1024 + k] = f2bf(v);
      }
      return;
    }
    it -= 16;
  }
  transpose_tile(cx, p.w_out + (size_t)layer * 1024 * 1024, 1024, wout, (it >> 4) * 64, (it & 15) * 64, smem);
}

DI void phase0a(const Ctx& cx, const Params& p, char* smem) {
  const int tid = cx.tid;
  float* mod = (float*)(p.ws + OFF_MOD);
  const int nconv = convert_items(0);
  const int nitems = 384 + nconv + 1;
  bool sc_ready = false;
  float* sc = (float*)smem;
  float* red = (float*)(smem + 36864);
  for (int it = cx.bid; it < nitems; it += cx.nblk) {
    if (it < 384) {
      if (!sc_ready) {
        for (int i = tid; i < 9 * 1024; i += 256) { float v = i < 8192 ? p.c[i] : p.c_ctx[i - 8192]; sc[i] = siluf(v); }
        sc_ready = true;
      }
      __syncthreads();
      const int layer = it / 96, col0 = (it % 96) * 32;
      const int c4 = tid & 7, kg = tid >> 3;
      const float* W = p.ada_w + (size_t)layer * 1024 * 3072 + col0 + c4 * 4;
      f32x4 acc[9];
#pragma unroll
      for (int c = 0; c < 9; ++c) acc[c] = (f32x4){0.f, 0.f, 0.f, 0.f};
      for (int i0 = 0; i0 < 32; i0 += 8) {
        f32x4 wv[8];
#pragma unroll
        for (int u = 0; u < 8; ++u) wv[u] = *(const f32x4*)(W + (size_t)(kg + 32 * (i0 + u)) * 3072);
#pragma unroll
        for (int u = 0; u < 8; ++u) {
          const int k = kg + 32 * (i0 + u);
#pragma unroll
          for (int c = 0; c < 9; ++c) { float s2 = sc[c * 1024 + k]; acc[c] += wv[u] * s2; }
        }
      }
#pragma unroll
      for (int c = 0; c < 9; ++c)
#pragma unroll
        for (int e = 0; e < 4; ++e) { float v = acc[c][e]; v += __shfl_xor(v, 8); v += __shfl_xor(v, 16); v += __shfl_xor(v, 32); acc[c][e] = v; }
      const int w = tid >> 6, lane = tid & 63;
      if (lane < 8) {
#pragma unroll
        for (int c = 0; c < 9; ++c)
#pragma unroll
          for (int e = 0; e < 4; ++e) red[(w * 9 + c) * 32 + lane * 4 + e] = acc[c][e];
      }
      __syncthreads();
      for (int o = tid; o < 9 * 32; o += 256) {
        int c = o >> 5, col = o & 31;
        float v = red[(0 * 9 + c) * 32 + col] + red[(1 * 9 + c) * 32 + col] + red[(2 * 9 + c) * 32 + col] + red[(3 * 9 + c) * 32 + col];
        v += p.ada_b[layer * 3072 + col0 + col];
        mod[((size_t)layer * 9 + c) * 3072 + col0 + col] = v;
      }
      __syncthreads();
    } else if (it < 384 + nconv) {
      __syncthreads();
      sc_ready = false;
      convert_item(cx, p, 0, it - 384, smem);
    } else {
      float* rc = (float*)(p.ws + OFF_ROPE); float* rs = rc + 2048;
      for (int i = tid; i < 2048; i += 256) {
        int pos = i >> 5, q = i & 31;
        float inv = __builtin_amdgcn_exp2f(-(float)q * (13.287712379549449f / 32.f));
        float rev = (float)pos * inv * 0.15915494309189535f;
        rc[i] = __builtin_amdgcn_cosf(rev); rs[i] = __builtin_amdgcn_sinf(rev);
      }
    }
  }
}

DI const float* resid_in(const Params& p, int layer, int b, int pos) {
  if (pos < CTXL) return (layer == 0 ? p.ctx : (const float*)(p.ws + OFF_XCTX)) + ((size_t)b * CTXL + pos) * D;
  return (layer == 0 ? p.x : (const float*)p.out) + ((size_t)b * SEQ + (pos - CTXL)) * D;
}
DI float* resid_out(const Params& p, int b, int pos) {
  if (pos < CTXL) return (float*)(p.ws + OFF_XCTX) + ((size_t)b * CTXL + pos) * D;
  return p.out + ((size_t)b * SEQ + (pos - CTXL)) * D;
}

DI void phase0b(const Ctx& cx, const Params& p) {
  const int lane = cx.tid & 63, wg = (cx.bid * 256 + cx.tid) >> 6, nw = cx.nblk * 4;
  const float* mod = (const float*)(p.ws + OFF_MOD);
  u16* H = (u16*)(p.ws + OFF_R0);
  for (int m0 = wg; m0 < MROWS; m0 += 2 * nw) {
    f32x4 xv[2][4], sh[2][4], sc[2][4];
#pragma unroll
    for (int q = 0; q < 2; ++q) {
      const int m = m0 + q * nw;
      if (m < MROWS) {
        const int b = m / LSEQ, pos = m % LSEQ;
        const float* xr = resid_in(p, 0, b, pos);
        const float* md = mod + (size_t)(0 * 9 + (pos < CTXL ? 8 : b)) * 3072;
#pragma unroll
        for (int i = 0; i < 4; ++i) { const int c = 4 * lane + 256 * i; xv[q][i] = *(const f32x4*)(xr + c); sh[q][i] = *(const f32x4*)(md + c); sc[q][i] = *(const f32x4*)(md + 1024 + c); }
      }
    }
#pragma unroll
    for (int q = 0; q < 2; ++q) {
      const int m = m0 + q * nw;
      if (m >= MROWS) continue;
#pragma unroll
      for (int i = 0; i < 4; ++i) {
        const int c = 4 * lane + 256 * i;
        f32x4 h = xv[q][i] * (sc[q][i] + 1.f) + sh[q][i];
        u32x2 o = {pk2(h[0], h[1]), pk2(h[2], h[3])};
        *(u32x2*)(H + (size_t)m * D + c) = o;
      }
    }
  }
}

DI void gemm_tile(const Ctx& cx, const u16* __restrict__ A, const u16* __restrict__ Bt, int row0, int col0, char* smem, f32x4 (&acc)[4][8]) {
  const int tid = cx.tid, lane = tid & 63, w = tid >> 6, wm = w >> 1, wn = w & 1, l15 = lane & 15, g = lane >> 4;
  const char* Abase = (const char*)(A + (size_t)row0 * 1024);
  const char* Bbase = (const char*)(Bt + (size_t)col0 * 1024);
  unsigned voA[4], voB[2];
#pragma unroll
  for (int i = 0; i < 4; ++i) { const int row = w * 64 + i * 16 + (lane >> 2), ch = (lane & 3) ^ ((-(row >> 2)) & 3); voA[i] = (unsigned)(row * 2048 + ch * 16); }
#pragma unroll
  for (int i = 0; i < 2; ++i) {
    const int row = w * 32 + i * 16 + (lane >> 2), ch = (lane & 3) ^ ((-(row >> 2)) & 3);
    const int r32 = row & 31, grow = (row & ~31) + 8 * ((r32 & 15) >> 2) + 4 * (r32 >> 4) + (r32 & 3);
    voB[i] = (unsigned)(grow * 2048 + ch * 16); }
  const int lA = w * 4096 + lane * 16, lB = 16384 + w * 2048 + lane * 16;
  const unsigned fo = (unsigned)(size_t)smem + l15 * 64 + ((g ^ ((-(l15 >> 2)) & 3)) << 4);
  const unsigned xbase = fo + 16384 + wn * 4096, ybase = fo + wm * 8192;
#pragma unroll
  for (int i = 0; i < 4; ++i)
#pragma unroll
    for (int j = 0; j < 8; ++j) acc[i][j] = (f32x4){0.f, 0.f, 0.f, 0.f};
#define GL_STAGE(kt_, so_) do { const char* ak_ = Abase + (kt_) * 64; const char* bk_ = Bbase + (kt_) * 64; char* sb_ = smem + (so_); \
    _Pragma("unroll") for (int i = 0; i < 4; ++i) { asm volatile("" : "+v"(voA[i]));   \
      __builtin_amdgcn_global_load_lds((const unsigned*)(ak_ + voA[i]), (unsigned*)(sb_ + lA + i * 1024), 16, 0, 0); } \
    _Pragma("unroll") for (int i = 0; i < 2; ++i) { asm volatile("" : "+v"(voB[i])); \
      __builtin_amdgcn_global_load_lds((const unsigned*)(bk_ + voB[i]), (unsigned*)(sb_ + lB + i * 1024), 16, 0, 0); } } while (0)
#define GL_STAGE_A(kt_, so_) do { const char* ak_ = Abase + (kt_) * 64; char* sb_ = smem + (so_); \
    _Pragma("unroll") for (int i = 0; i < 4; ++i) { asm volatile("" : "+v"(voA[i])); \
      __builtin_amdgcn_global_load_lds((const unsigned*)(ak_ + voA[i]), (unsigned*)(sb_ + lA + i * 1024), 16, 0, 0); } } while (0)
#define GL_STAGE_B(kt_, so_) do { const char* bk_ = Bbase + (kt_) * 64; char* sb_ = smem + (so_); \
    _Pragma("unroll") for (int i = 0; i < 2; ++i) { asm volatile("" : "+v"(voB[i])); \
      __builtin_amdgcn_global_load_lds((const unsigned*)(bk_ + voB[i]), (unsigned*)(sb_ + lB + i * 1024), 16, 0, 0); } } while (0)
#define DS_RD(dst, addr, off) asm volatile("ds_read_b128 %0, %1 offset:%2" : "=v"(dst) : "v"(addr), "n"(off))
  GL_STAGE(0, 0); GL_STAGE(1, 24576);
  if (cx.bid & 256) __builtin_amdgcn_s_sleep(10);
  int sc = 0;
  for (int kt = 0; kt < 32; ++kt) {
    if (kt < 31) asm volatile("s_waitcnt vmcnt(6)" ::: "memory");
    else asm volatile("s_waitcnt vmcnt(0)" ::: "memory");
    __builtin_amdgcn_s_barrier();
    const int sn = sc == 0 ? 49152 : sc - 24576;
    const unsigned xa = xbase + sc, ya = ybase + sc;
    bf16x8 xf[4], yf[8];
    DS_RD(xf[0], xa, 0); DS_RD(xf[1], xa, 1024); DS_RD(xf[2], xa, 2048); DS_RD(xf[3], xa, 3072);
    DS_RD(yf[0], ya, 0); DS_RD(yf[1], ya, 1024); DS_RD(yf[2], ya, 2048); DS_RD(yf[3], ya, 3072);
    DS_RD(yf[4], ya, 4096); DS_RD(yf[5], ya, 5120); DS_RD(yf[6], ya, 6144); DS_RD(yf[7], ya, 7168);
    if (kt + 2 < 32) GL_STAGE_A(kt + 2, sn);
    asm volatile("s_waitcnt lgkmcnt(4)" : "+v"(xf[0]), "+v"(xf[1]), "+v"(xf[2]), "+v"(xf[3]), "+v"(yf[0]), "+v"(yf[1]), "+v"(yf[2]), "+v"(yf[3]) :: "memory");
    __builtin_amdgcn_sched_barrier(0);
#pragma unroll
    for (int i = 0; i < 4; ++i)
#pragma unroll
      for (int j = 0; j < 4; ++j) acc[i][j] = mfma16(xf[i], yf[j], acc[i][j]);
    __builtin_amdgcn_sched_barrier(0);
    if (kt + 2 < 32) GL_STAGE_B(kt + 2, sn);
    asm volatile("s_waitcnt lgkmcnt(0)" : "+v"(yf[4]), "+v"(yf[5]), "+v"(yf[6]), "+v"(yf[7]) :: "memory");
    __builtin_amdgcn_sched_barrier(0);
#pragma unroll
    for (int i = 0; i < 4; ++i)
#pragma unroll
      for (int j = 4; j < 8; ++j) acc[i][j] = mfma16(xf[i], yf[j], acc[i][j]);
    __builtin_amdgcn_sched_barrier(0);
    sc = sc == 49152 ? 0 : sc + 24576;
  }
#undef GL_STAGE
#undef GL_STAGE_A
#undef GL_STAGE_B
#undef DS_RD
  __builtin_amdgcn_s_barrier();
}

DI void store_T(const Ctx& cx, const f32x4 (&acc)[4][8], u16* dst, int ld, int row0, int fcol0, float scale, char* smem) {
  const int lane = cx.tid & 63, w = cx.tid >> 6, wm = w >> 1, wn = w & 1, l15 = lane & 15, g = lane >> 4;
  char* img = smem + w * 18432;
#pragma unroll
  for (int yj = 0; yj < 8; ++yj)
#pragma unroll
    for (int xp = 0; xp < 2; ++xp) {
      f32x4 v0 = acc[2 * xp][yj] * scale, v1 = acc[2 * xp + 1][yj] * scale;
      u32x4 o = {pk2(v0[0], v0[1]), pk2(v0[2], v0[3]), pk2(v1[0], v1[1]), pk2(v1[2], v1[3])};
      *(u32x4*)(img + (yj * 16 + l15) * 144 + xp * 64 + 16 * g) = o;
    }
  __builtin_amdgcn_fence(__ATOMIC_RELEASE, "wavefront");
  asm volatile("s_waitcnt lgkmcnt(0)" ::: "memory");
  char* base = (char*)(dst + (size_t)(row0 + wm * 128) * ld + fcol0 + wn * 64) + (lane & 7) * 16;
  const int tr = lane >> 3;
#pragma unroll
  for (int k = 0; k < 16; ++k) {
    const int t = 8 * k + tr;
    u32x4 v = *(const u32x4*)(img + t * 144 + (lane & 7) * 16);
    *(u32x4*)(base + (size_t)((unsigned)(t * ld) * 2u)) = v;
  }
  __syncthreads();
}
DI void store_VT(const Ctx& cx, const f32x4 (&acc)[4][8], u16* vt, int b, int pos0, int fcol0, char* smem) {
  const int tid = cx.tid, lane = tid & 63, w = tid >> 6, wm = w >> 1, wn = w & 1, l15 = lane & 15, g = lane >> 4;
#pragma unroll
  for (int xi = 0; xi < 4; ++xi)
#pragma unroll
    for (int yj = 0; yj < 8; ++yj) {
      const unsigned p01 = pk2(acc[xi][yj][0], acc[xi][yj][1]), p23 = pk2(acc[xi][yj][2], acc[xi][yj][3]);
      const int f = wn * 64 + (xi >> 1) * 32 + 8 * g + 4 * (xi & 1), t = wm * 128 + yj * 16 + l15;
      char* d = smem + f * 528 + t * 2;
      *(u16*)(d) = (u16)(p01 & 0xffffu); *(u16*)(d + 528) = (u16)(p01 >> 16);
      *(u16*)(d + 1056) = (u16)(p23 & 0xffffu); *(u16*)(d + 1584) = (u16)(p23 >> 16);
    }
  __syncthreads();
#pragma unroll
  for (int i = 0; i < 16; ++i) {
    const int c = tid + 256 * i, f = c >> 5, tc = c & 31;
    u32x4 v = *(const u32x4*)(smem + f * 528 + tc * 16);
    *(u32x4*)(vt + (size_t)((unsigned)((b * 1024 + fcol0 + f) * LSEQ + pos0 + tc * 8))) = v;
  }
  __syncthreads();
}

DI void gemm_phase(const Ctx& cx, const Params& p, int kind, int layer, char* smem) {
  const int NC = kind == 0 ? 25 : (kind == 1 ? 32 : 8);
  const u16* A = (const u16*)(p.ws + OFF_R0);
  const u16* Bt = (const u16*)(p.ws + (kind == 2 ? OFF_WOUT : OFF_WIN));
  const bool last = (layer == 3);
  const int nitems = 72 * NC;
  for (int it = cx.bid; it < nitems; it += cx.nblk) {
    const int xcd = it & 7, j = it >> 3;
    const int grp = j / 72, rem = j - grp * 72, gw = min(8, NC - grp * 8);
    const int rt = (rem / gw) * 8 + xcd, ct = grp * 8 + rem % gw;
    const int b = rt / 9, pos0 = (rt % 9) * 256, row0 = rt * 256, col0 = ct * 128;
    const bool isctx = pos0 < CTXL;
    if (kind == 1) { if (last && isctx && (ct < 8 || ct >= 24)) continue; }
    else if (kind == 2) { if (last && isctx) continue; }
    f32x4 acc[4][8];
    gemm_tile(cx, A, Bt, row0, col0, smem, acc);
    Ctx cx2 = cx; asm volatile("" : "+v"(cx2.tid));
    if (kind == 0) {
      if (ct < 8) store_T(cx2, acc, (u16*)(p.ws + OFF_R1), 1024, row0, col0, ct < 4 ? 0.08838834764831845f : 1.f, smem);
      else if (ct < 16) store_VT(cx2, acc, (u16*)(p.ws + OFF_R3), b, pos0, col0 - 1024, smem);
      else if (ct < 24) store_T(cx2, acc, (u16*)(p.ws + OFF_R4), 1024, row0, col0 - 2048, 1.f, smem);
      else {
        const int lane = cx2.tid & 63, w = cx2.tid >> 6, wm = w >> 1, wn = w & 1, l15 = lane & 15, g = lane >> 4;
        u16* low = (u16*)(p.ws + OFF_LOW);
        if (wn == 0) {
#pragma unroll
          for (int yj = 0; yj < 8; ++yj) {
            const unsigned token = row0 + wm * 128 + yj * 16 + l15;
            f32x4 v0 = acc[0][yj], v1 = acc[1][yj];
            u32x4 o = {pk2(v0[0], v0[1]), pk2(v0[2], v0[3]), pk2(v1[0], v1[1]), pk2(v1[2], v1[3])};
            *(u32x4*)(low + (size_t)(token * 32u + 8 * g)) = o;
          }
        }
      }
    } else if (kind == 1) {
      if (ct < 8) store_T(cx2, acc, (u16*)(p.ws + OFF_R1), 1024, row0, col0, 0.125f * 1.4426950408889634f, smem);
      else if (ct < 16) store_T(cx2, acc, (u16*)(p.ws + OFF_R2), 1024, row0, col0 - 1024, 1.f, smem);
      else if (ct < 24) store_VT(cx2, acc, (u16*)(p.ws + OFF_R3), b, pos0, col0 - 2048, smem);
      else store_T(cx2, acc, (u16*)(p.ws + OFF_R4), 1024, row0, col0 - 3072, 1.f, smem);
    } else {
      store_T(cx2, acc, (u16*)(p.ws + OFF_R2), 1024, row0, col0, 1.f, smem);
    }
  }
}

DI void gla_prep_phase(const Ctx& cx, const Params& p, int layer, char* smem) {
  const int tid = cx.tid, lane = tid & 63, w = tid >> 6, l15 = lane & 15, g = lane >> 4;
  const int jl = layer >> 1;
  char* qS = smem; char* kS = smem + 16384;
  float* lowS = (float*)(smem + 32768);
  float* totS = (float*)(smem + 32768 + 4096);
  const u16* QK = (const u16*)(p.ws + OFF_R1);
  const u16* LOW = (const u16*)(p.ws + OFF_LOW);
  u16* QT = (u16*)(p.ws + OFF_R2); u16* KE = (u16*)(p.ws + OFF_R5); u16* ATT = (u16*)(p.ws + OFF_R6);
  float* DEC = (float*)(p.ws + OFF_DEC);
  const float* ropeC = (const float*)(p.ws + OFF_ROPE); const float* ropeS = ropeC + 2048;
  const int d6 = tid & 63, tq = tid >> 6;
  float* ropeL = (float*)(smem + 40960);
  for (int i = tid; i < 4096; i += 256) ropeL[i] = ropeC[i];
  for (int it = cx.bid; it < NB * NCHUNK * 8; it += cx.nblk) {
    const int dir = it & 1, h = (it >> 1) & 3, bn = it >> 3, n = bn % NCHUNK, b = bn / NCHUNK;
    const size_t m0 = (size_t)b * LSEQ + n * 64;
    __syncthreads();
#pragma unroll
    for (int i = 0; i < 4; ++i) {
      int c = tid + 256 * i, row = c >> 4, ch = c & 15;
      u32x4 vq = *(const u32x4*)(QK + (m0 + row) * 1024 + h * 128 + ch * 8);
      u32x4 vk = *(const u32x4*)(QK + (m0 + row) * 1024 + 512 + h * 128 + ch * 8);
      int o = row * 256 + ((ch ^ (row & 15)) << 4);
      *(u32x4*)(qS + o) = vq; *(u32x4*)(kS + o) = vk;
    }
#pragma unroll
    for (int i = 0; i < 4; ++i) {
      int idx = tid + 256 * i, t = idx >> 4, r = idx & 15;
      lowS[idx] = bf2f(LOW[(m0 + t) * 32 + dir * 16 + r]);
    }
    float w2a[16], w2b[16];
    const float* w2 = p.gla_dec_w2 + ((size_t)(jl * 2 + dir) * 16) * 512 + h * 128 + d6;
#pragma unroll
    for (int r = 0; r < 16; ++r) { w2a[r] = w2[r * 512]; w2b[r] = w2[r * 512 + 64]; }
    const float ba = p.gla_dec_b[(jl * 2 + dir) * 512 + h * 128 + d6], bb = p.gla_dec_b[(jl * 2 + dir) * 512 + h * 128 + d6 + 64];
    __syncthreads();
    float la0[16], la1[16];
    float s0 = 0.f, s1 = 0.f;
#pragma unroll
    for (int tt = 0; tt < 16; ++tt) {
      const int t = tq * 16 + tt;
      float x0 = ba, x1 = bb;
#pragma unroll
      for (int r4 = 0; r4 < 4; ++r4) {
        f32x4 lv = *(const f32x4*)(lowS + t * 16 + r4 * 4);
#pragma unroll
        for (int e = 0; e < 4; ++e) { x0 += lv[e] * w2a[r4 * 4 + e]; x1 += lv[e] * w2b[r4 * 4 + e]; }
      }
      float l0 = (fminf(x0, 0.f) - __logf(1.f + __expf(-fabsf(x0)))) * 0.0625f;
      float l1 = (fminf(x1, 0.f) - __logf(1.f + __expf(-fabsf(x1)))) * 0.0625f;
      la0[tt] = l0; la1[tt] = l1; s0 += l0; s1 += l1;
    }
    totS[tq * 128 + d6] = s0; totS[tq * 128 + d6 + 64] = s1;
    __syncthreads();
    float off0 = 0.f, off1 = 0.f, tot0 = 0.f, tot1 = 0.f;
#pragma unroll
    for (int q = 0; q < 4; ++q) {
      float a = totS[q * 128 + d6], bq = totS[q * 128 + d6 + 64];
      tot0 += a; tot1 += bq;
      bool inc = dir == 0 ? (q < tq) : (q > tq);
      if (inc) { off0 += a; off1 += bq; }
    }
    const float dec0 = __expf(tot0), dec1 = __expf(tot1);
    if (tq == 0) { DEC[(size_t)it * 128 + d6] = dec0; DEC[(size_t)it * 128 + d6 + 64] = dec1; }
    const bool do_rope = n >= 4;
    unsigned ke0[8], ke1[8];
    float run0 = 0.f, run1 = 0.f, keprev0 = 0.f, keprev1 = 0.f;
#pragma unroll
    for (int hb = 0; hb < 2; ++hb) {
      unsigned qv[8], kv[8]; float csv[8], snv[8];
#pragma unroll
      for (int t8 = 0; t8 < 8; ++t8) {
        const int tt = hb * 8 + t8, t = tq * 16 + tt;
        const int o0 = t * 256 + (((d6 >> 3) ^ tt) << 4) + (d6 & 7) * 2;
        const int o1 = t * 256 + ((((d6 >> 3) + 8) ^ tt) << 4) + (d6 & 7) * 2;
        qv[t8] = (unsigned)*(const u16*)(qS + o0) | ((unsigned)*(const u16*)(qS + o1) << 16);
        kv[t8] = (unsigned)*(const u16*)(kS + o0) | ((unsigned)*(const u16*)(kS + o1) << 16);
        const int pos = d6 < 32 ? (do_rope ? n - 4 : 0) : t;
        csv[t8] = ropeL[pos * 32 + (d6 & 31)]; snv[t8] = ropeL[2048 + pos * 32 + (d6 & 31)];
      }
      asm volatile("" ::: "memory");
#pragma unroll
      for (int t8 = 0; t8 < 8; ++t8) {
        const int tt = hb * 8 + t8, t = tq * 16 + tt;
        const float rp0 = run0, rp1 = run1;
        run0 += la0[tt]; run1 += la1[tt];
        const float c0 = dir == 0 ? off0 + run0 : off0 + (s0 - rp0), c1 = dir == 0 ? off1 + run1 : off1 + (s1 - rp1);
        const float qb0 = dir == 0 ? c0 : c0 - la0[tt], qb1 = dir == 0 ? c1 : c1 - la1[tt];
        const int o0 = t * 256 + (((d6 >> 3) ^ tt) << 4) + (d6 & 7) * 2;
        const int o1 = t * 256 + ((((d6 >> 3) + 8) ^ tt) << 4) + (d6 & 7) * 2;
        float q0 = bf_lo(qv[t8]), q1 = bf_hi(qv[t8]);
        float k0 = bf_lo(kv[t8]), k1 = bf_hi(kv[t8]);
        if (do_rope) {
          const float cs = csv[t8], sn = snv[t8];
          float a = q0 * cs - q1 * sn, bq = q0 * sn + q1 * cs; q0 = a; q1 = bq;
          a = k0 * cs - k1 * sn; bq = k0 * sn + k1 * cs; k0 = a; k1 = bq;
        }
        const float kt0 = k0 * __expf(-c0), kt1 = k1 * __expf(-c1);
        *(u16*)(qS + o0) = f2bf(q0 * __expf(qb0)); *(u16*)(qS + o1) = f2bf(q1 * __expf(qb1));
        *(u16*)(kS + o0) = f2bf(kt0); *(u16*)(kS + o1) = f2bf(kt1);
        const float e0 = kt0 * dec0, e1 = kt1 * dec1;
        if (tt & 1) { ke0[tt >> 1] = pk2(keprev0, e0); ke1[tt >> 1] = pk2(keprev1, e1); } else { keprev0 = e0; keprev1 = e1; }
      }
      asm volatile("" ::: "memory");
    }
    {
      char* kimg = smem + 57344;
      u32x4 a = {ke0[0], ke0[1], ke0[2], ke0[3]}, bq = {ke0[4], ke0[5], ke0[6], ke0[7]};
      *(u32x4*)(kimg + d6 * 128 + (((tq * 2) ^ (d6 & 7)) << 4)) = a; *(u32x4*)(kimg + d6 * 128 + (((tq * 2 + 1) ^ (d6 & 7)) << 4)) = bq;
      u32x4 c = {ke1[0], ke1[1], ke1[2], ke1[3]}, d = {ke1[4], ke1[5], ke1[6], ke1[7]};
      *(u32x4*)(kimg + (d6 + 64) * 128 + (((tq * 2) ^ (d6 & 7)) << 4)) = c; *(u32x4*)(kimg + (d6 + 64) * 128 + (((tq * 2 + 1) ^ (d6 & 7)) << 4)) = d;
    }
    __syncthreads();
#pragma unroll
    for (int i = 0; i < 4; ++i) {
      const int c = tid + 256 * i, row = c >> 3, ch = c & 7;
      u32x4 v = *(const u32x4*)(smem + 57344 + row * 128 + ((ch ^ (row & 7)) << 4));
      *(u32x4*)(KE + (size_t)it * 8192 + c * 8) = v;
    }
#pragma unroll
    for (int i = 0; i < 4; ++i) {
      int c = tid + 256 * i, row = c >> 4, ch = c & 15;
      u32x4 v = *(const u32x4*)(qS + row * 256 + ((ch ^ (row & 15)) << 4));
      *(u32x4*)(QT + (size_t)it * 8192 + c * 8) = v;
    }
    {
      f32x4 at[4];
#pragma unroll
      for (int st = 0; st < 4; ++st) at[st] = (f32x4){0.f, 0.f, 0.f, 0.f};
#pragma unroll
      for (int kk = 0; kk < 4; ++kk) {
        const int co = ((kk * 4 + g) ^ l15) << 4;
        bf16x8 qf = *(const bf16x8*)(qS + (16 * w + l15) * 256 + co);
#pragma unroll
        for (int st = 0; st < 4; ++st) {
          bf16x8 kf = *(const bf16x8*)(kS + (16 * st + l15) * 256 + co);
          at[st] = mfma16(kf, qf, at[st]);
        }
      }
      const int t = 16 * w + l15;
#pragma unroll
      for (int st = 0; st < 4; ++st) {
        float v[4];
#pragma unroll
        for (int jj = 0; jj < 4; ++jj) { int s = 16 * st + 4 * g + jj; bool keep = dir == 0 ? (s <= t) : (s > t); v[jj] = keep ? at[st][jj] : 0.f; }
        u32x2 o = {pk2(v[0], v[1]), pk2(v[2], v[3])};
        *(u32x2*)(ATT + (size_t)it * 4096 + t * 64 + 16 * st + 4 * g) = o;
      }
    }
  }
}

DI void gla_chain_phase(const Ctx& cx, const Params& p, char* smem) {
  const int tid = cx.tid, lane = tid & 63, w = tid >> 6, l15 = lane & 15, g = lane >> 4;
  char* qtS = smem; char* keS = smem + 16384; char* atS = smem + 32768; char* vtS = smem + 40960; float* decS = (float*)(smem + 49152);
  const u16* QT = (const u16*)(p.ws + OFF_R2); const u16* KE = (const u16*)(p.ws + OFF_R5); const u16* ATT = (const u16*)(p.ws + OFF_R6);
  const u16* VT = (const u16*)(p.ws + OFF_R3); const float* DEC = (const float*)(p.ws + OFF_DEC);
  const int sw7 = (l15 >> 1) & 7;
  for (int it = cx.bid; it < 256; it += cx.nblk) {
    const int sl = it & 3, dir = (it >> 2) & 1, h = (it >> 3) & 3, b = it >> 5;
    u16* O = (u16*)(p.ws + (dir == 0 ? OFF_R1 : OFF_R0));
    f32x4 S[8]; bf16x8 Sbf[4];
#pragma unroll
    for (int a = 0; a < 8; ++a) S[a] = (f32x4){0.f, 0.f, 0.f, 0.f};
#pragma unroll
    for (int kk = 0; kk < 4; ++kk) Sbf[kk] = (bf16x8){0, 0, 0, 0, 0, 0, 0, 0};
    u32x4 pf[12]; f32x4 pfd = {0.f, 0.f, 0.f, 0.f};
    auto chunk_of = [&](int j) { return dir == 0 ? j : (j < 4 ? 3 - j : 39 - j); };
    auto issue = [&](int j) {
      const int n = chunk_of(j);
      const size_t pi = ((size_t)(b * NCHUNK + n) * 4 + h) * 2 + dir;
      const char* qb = (const char*)(QT + pi * 8192); const char* kb = (const char*)(KE + pi * 8192); const char* ab = (const char*)(ATT + pi * 4096);
      const char* vb = (const char*)(VT + ((size_t)b * 1024 + h * 256 + sl * 64) * LSEQ + n * 64);
      const unsigned lo = (unsigned)tid * 16u;
#pragma unroll
      for (int i = 0; i < 4; ++i) pf[i] = *(const u32x4*)(qb + lo + i * 4096);
#pragma unroll
      for (int i = 0; i < 4; ++i) pf[4 + i] = *(const u32x4*)(kb + lo + i * 4096);
#pragma unroll
      for (int i = 0; i < 2; ++i) pf[8 + i] = *(const u32x4*)(ab + lo + i * 4096);
#pragma unroll
      for (int i = 0; i < 2; ++i) { const unsigned c = tid + 256 * i, row = c >> 3, ch = c & 7; pf[10 + i] = *(const u32x4*)(vb + (row * LSEQ + ch * 8) * 2u); }
      if (tid < 32) pfd = *(const f32x4*)(DEC + pi * 128 + tid * 4);
    };
    auto commit = [&]() {
#pragma unroll
      for (int i = 0; i < 4; ++i) { int c = tid + 256 * i, row = c >> 4, ch = c & 15; *(u32x4*)(qtS + row * 256 + ((ch ^ (row & 15)) << 4)) = pf[i]; }
#pragma unroll
      for (int i = 0; i < 4; ++i) { int c = tid + 256 * i, row = c >> 3, ch = c & 7; *(u32x4*)(keS + row * 128 + ((ch ^ ((row >> 1) & 7)) << 4)) = pf[4 + i]; }
#pragma unroll
      for (int i = 0; i < 2; ++i) { int c = tid + 256 * i, row = c >> 3, ch = c & 7; *(u32x4*)(atS + row * 128 + ((ch ^ ((row >> 1) & 7)) << 4)) = pf[8 + i]; }
#pragma unroll
      for (int i = 0; i < 2; ++i) { int c = tid + 256 * i, row = c >> 3, ch = c & 7; *(u32x4*)(vtS + row * 128 + ((ch ^ ((row >> 1) & 7)) << 4)) = pf[10 + i]; }
      if (tid < 32) *(f32x4*)(decS + tid * 4) = pfd;
    };
    __syncthreads();
    issue(0); commit();
    __syncthreads();
    for (int j = 0; j < NCHUNK; ++j) {
      const int n = chunk_of(j);
      if (j + 1 < NCHUNK) issue(j + 1);
#define SB __builtin_amdgcn_sched_barrier(0)
#define LOADQ(QF, KK0) do { _Pragma("unroll") for (int k2 = 0; k2 < 2; ++k2) _Pragma("unroll") for (int tt = 0; tt < 4; ++tt) { \
        const int row = 16 * tt + l15; const int e0 = 32 * ((KK0) + k2) + 4 * g, e1 = e0 + 16; \
        u32x2 lo = *(const u32x2*)(qtS + row * 256 + (((e0 >> 3) ^ l15) << 4) + (e0 & 7) * 2); \
        u32x2 hi = *(const u32x2*)(qtS + row * 256 + (((e1 >> 3) ^ l15) << 4) + (e1 & 7) * 2); \
        u32x4 q4 = {lo[0], lo[1], hi[0], hi[1]}; QF[k2][tt] = __builtin_bit_cast(bf16x8, q4); } } while (0)
      bf16x8 vf[2], af[4][2];
#pragma unroll
      for (int kk = 0; kk < 2; ++kk) vf[kk] = *(const bf16x8*)(vtS + (16 * w + l15) * 128 + (((kk * 4 + g) ^ sw7) << 4));
#pragma unroll
      for (int tt = 0; tt < 4; ++tt)
#pragma unroll
        for (int kk = 0; kk < 2; ++kk) af[tt][kk] = *(const bf16x8*)(atS + (16 * tt + l15) * 128 + (((kk * 4 + g) ^ sw7) << 4));
      bf16x8 qa[2][4];
      LOADQ(qa, 0);
      SB;
      f32x4 o[4];
#pragma unroll
      for (int tt = 0; tt < 4; ++tt) {
        o[tt] = mfma16(vf[0], af[tt][0], (f32x4){0.f, 0.f, 0.f, 0.f});
        o[tt] = mfma16(vf[1], af[tt][1], o[tt]);
      }
      SB;
      bf16x8 qb[2][4];
      LOADQ(qb, 2);
      SB;
#pragma unroll
      for (int k2 = 0; k2 < 2; ++k2)
#pragma unroll
        for (int tt = 0; tt < 4; ++tt) o[tt] = mfma16(Sbf[k2], qa[k2][tt], o[tt]);
      SB;
#define LOADK(KF, DF, A0) do { _Pragma("unroll") for (int a = 0; a < 2; ++a) { DF[a] = *(const f32x4*)(decS + 16 * ((A0) + a) + 4 * g); \
        _Pragma("unroll") for (int kk = 0; kk < 2; ++kk) KF[a][kk] = *(const bf16x8*)(keS + (16 * ((A0) + a) + l15) * 128 + (((kk * 4 + g) ^ sw7) << 4)); } } while (0)
#define SUPD(KF, DF, A0) do { _Pragma("unroll") for (int a = 0; a < 2; ++a) { S[(A0) + a] *= DF[a]; \
        S[(A0) + a] = mfma16(KF[a][0], vf[0], S[(A0) + a]); S[(A0) + a] = mfma16(KF[a][1], vf[1], S[(A0) + a]); } } while (0)
      bf16x8 k0[2][2], k1[2][2]; f32x4 d0[2], d1[2];
      LOADK(k0, d0, 0);
      SB;
#pragma unroll
      for (int k2 = 0; k2 < 2; ++k2)
#pragma unroll
        for (int tt = 0; tt < 4; ++tt) o[tt] = mfma16(Sbf[2 + k2], qb[k2][tt], o[tt]);
      SB;
      LOADK(k1, d1, 2);
      SB;
      SUPD(k0, d0, 0);
      SB;
#pragma unroll
      for (int tt = 0; tt < 4; ++tt) {
        size_t m = (size_t)b * LSEQ + n * 64 + 16 * tt + l15;
        u32x2 ov = {pk2(o[tt][0], o[tt][1]), pk2(o[tt][2], o[tt][3])};
        *(u32x2*)(O + m * 1024 + h * 256 + sl * 64 + 16 * w + 4 * g) = ov;
      }
      LOADK(k0, d0, 4);
      SB;
      SUPD(k1, d1, 2);
      SB;
      LOADK(k1, d1, 6);
      SB;
      SUPD(k0, d0, 4);
      SB;
      SUPD(k1, d1, 6);
#undef LOADK
#undef SUPD
#undef SB
#undef LOADQ
#pragma unroll
      for (int kk = 0; kk < 4; ++kk) {
        u32x4 s4 = {pk2(S[2 * kk][0], S[2 * kk][1]), pk2(S[2 * kk][2], S[2 * kk][3]), pk2(S[2 * kk + 1][0], S[2 * kk + 1][1]), pk2(S[2 * kk + 1][2], S[2 * kk + 1][3])};
        Sbf[kk] = __builtin_bit_cast(bf16x8, s4);
      }
      __syncthreads();
      if (j + 1 < NCHUNK) { commit(); __syncthreads(); }
    }
  }
}

DI void gla_merge_phase(const Ctx& cx, const Params& p, int layer) {
  const int lane = cx.tid & 63, wg = (cx.bid * 256 + cx.tid) >> 6, nw = cx.nblk * 4;
  const u16* OF = (const u16*)(p.ws + OFF_R1); u16* OB = (u16*)(p.ws + OFF_R0); const u16* G = (const u16*)(p.ws + OFF_R4);
  const float* ng = p.gla_norm_g + (layer >> 1) * 256 + (lane & 15) * 16;
  float ngv[16];
#pragma unroll
  for (int i = 0; i < 16; ++i) ngv[i] = ng[i];
  for (int m0 = wg; m0 < MROWS; m0 += 2 * nw) {
    float o[2][16], gv[2][16];
#pragma unroll
    for (int q = 0; q < 2; ++q) {
      const int m = m0 + q * nw;
      if (m < MROWS) {
        const size_t base = (size_t)m * 1024 + lane * 16;
#pragma unroll
        for (int hlf = 0; hlf < 2; ++hlf) {
          u32x4 a = *(const u32x4*)(OF + base + hlf * 8), bq = *(const u32x4*)(OB + base + hlf * 8), c = *(const u32x4*)(G + base + hlf * 8);
#pragma unroll
          for (int e = 0; e < 4; ++e) {
            o[q][hlf * 8 + 2 * e] = bf_lo(a[e]) + bf_lo(bq[e]); o[q][hlf * 8 + 2 * e + 1] = bf_hi(a[e]) + bf_hi(bq[e]);
            gv[q][hlf * 8 + 2 * e] = bf_lo(c[e]); gv[q][hlf * 8 + 2 * e + 1] = bf_hi(c[e]);
          }
        }
      }
    }
#pragma unroll
    for (int q = 0; q < 2; ++q) {
      const int m = m0 + q * nw;
      if (m >= MROWS) continue;
      const size_t base = (size_t)m * 1024 + lane * 16;
      float ss = 0.f;
#pragma unroll
      for (int i = 0; i < 16; ++i) ss += o[q][i] * o[q][i];
      ss += __shfl_xor(ss, 1); ss += __shfl_xor(ss, 2); ss += __shfl_xor(ss, 4); ss += __shfl_xor(ss, 8);
      const float r = rsqrtf(ss * (1.f / 256.f) + 1e-6f);
      unsigned ov[8];
#pragma unroll
      for (int e = 0; e < 8; ++e) {
        float v0 = o[q][2 * e] * r * ngv[2 * e] * siluf(gv[q][2 * e]), v1 = o[q][2 * e + 1] * r * ngv[2 * e + 1] * siluf(gv[q][2 * e + 1]);
        ov[e] = pk2(v0, v1);
      }
      u32x4 w0 = {ov[0], ov[1], ov[2], ov[3]}, w1 = {ov[4], ov[5], ov[6], ov[7]};
      *(u32x4*)(OB + base) = w0; *(u32x4*)(OB + base + 8) = w1;
    }
  }
}

DI void ln_phase(const Ctx& cx, const Params& p, int layer, char* smem) {
  const int lane = cx.tid & 63, wg = (cx.bid * 256 + cx.tid) >> 6, nw = cx.nblk * 4;
  const float* mod = (const float*)(p.ws + OFF_MOD);
  const u16* Y = (const u16*)(p.ws + OFF_R2);
  u16* H = (u16*)(p.ws + OFF_R0);
  const bool last = layer == 3;
  f32x4 gg[4], bb[4];
#pragma unroll
  for (int i = 0; i < 4; ++i) { const int c = 4 * lane + 256 * i; gg[i] = *(const f32x4*)(p.ln_g + layer * 1024 + c); bb[i] = *(const f32x4*)(p.ln_b + layer * 1024 + c); }
  const int rpw = (MROWS + nw - 1) / nw;
  const int mbeg = wg * rpw, mend = min(mbeg + rpw, MROWS);
  int cur_cond = -1;
  f32x4 gtv[4], shv[4], scv[4];
  for (int m0 = mbeg; m0 < mend; m0 += 2) {
    float v[2][16];
    float sum[2] = {0.f, 0.f};
    bool act[2];
    f32x4 xv[2][4]; u32x2 yv[2][4];
#pragma unroll
    for (int q = 0; q < 2; ++q) {
      const int m = m0 + q;
      const int b = m / LSEQ, pos = m % LSEQ;
      act[q] = (m < mend) && !(last && pos < CTXL);
      if (act[q]) {
        const float* xr = resid_in(p, layer, b, pos);
#pragma unroll
        for (int i = 0; i < 4; ++i) { const int c = 4 * lane + 256 * i; xv[q][i] = *(const f32x4*)(xr + c); yv[q][i] = *(const u32x2*)(Y + (size_t)m * 1024 + c); }
      }
    }
#pragma unroll
    for (int q = 0; q < 2; ++q) {
      if (!act[q]) continue;
      const int m = m0 + q;
      const int b = m / LSEQ, pos = m % LSEQ;
      const int cond = pos < CTXL ? 8 : b;
      if (cond != cur_cond) {
        const float* md = mod + (size_t)(layer * 9 + cond) * 3072;
        const float* mdn = mod + (size_t)((layer + 1) * 9 + cond) * 3072;
#pragma unroll
        for (int i = 0; i < 4; ++i) {
          const int c = 4 * lane + 256 * i;
          gtv[i] = *(const f32x4*)(md + 2048 + c);
          if (!last) { shv[i] = *(const f32x4*)(mdn + c); scv[i] = *(const f32x4*)(mdn + 1024 + c); }
        }
        cur_cond = cond;
      }
#pragma unroll
      for (int i = 0; i < 4; ++i) {
        v[q][4 * i + 0] = ALPHA * xv[q][i][0] + gtv[i][0] * bf_lo(yv[q][i][0]); v[q][4 * i + 1] = ALPHA * xv[q][i][1] + gtv[i][1] * bf_hi(yv[q][i][0]);
        v[q][4 * i + 2] = ALPHA * xv[q][i][2] + gtv[i][2] * bf_lo(yv[q][i][1]); v[q][4 * i + 3] = ALPHA * xv[q][i][3] + gtv[i][3] * bf_hi(yv[q][i][1]);
        sum[q] += v[q][4 * i] + v[q][4 * i + 1] + v[q][4 * i + 2] + v[q][4 * i + 3];
      }
      float* xo = resid_out(p, b, pos);
      float sm = sum[q];
#pragma unroll
      for (int s2 = 1; s2 < 64; s2 <<= 1) sm += __shfl_xor(sm, s2);
      const float mu = sm * (1.f / 1024.f);
      float var = 0.f;
#pragma unroll
      for (int i = 0; i < 16; ++i) { float d = v[q][i] - mu; var += d * d; }
#pragma unroll
      for (int s2 = 1; s2 < 64; s2 <<= 1) var += __shfl_xor(var, s2);
      const float rstd = rsqrtf(var * (1.f / 1024.f) + 1e-5f);
#pragma unroll
      for (int i = 0; i < 4; ++i) {
        const int c = 4 * lane + 256 * i;
        f32x4 xn;
#pragma unroll
        for (int e = 0; e < 4; ++e) xn[e] = (v[q][4 * i + e] - mu) * rstd * gg[i][e] + bb[i][e];
        *(f32x4*)(xo + c) = xn;
        if (!last) {
          f32x4 hh = xn * (scv[i] + 1.f) + shv[i];
          u32x2 o = {pk2(hh[0], hh[1]), pk2(hh[2], hh[3])};
          *(u32x2*)(H + (size_t)m * 1024 + c) = o;
        }
      }
    }
  }
  if (!last) {
    const int nconv = convert_items(layer + 1);
    for (int it = cx.bid; it < nconv; it += cx.nblk) convert_item(cx, p, layer + 1, it, smem);
  }
}

DI void na_attn_phase(const Ctx& cx, const Params& p, int layer, char* smem) {
  const int tid = cx.tid, lane = tid & 63, w = tid >> 6, l15 = lane & 15, g = lane >> 4;
  const bool need_ctx = layer < 3;
  const int RPI = need_ctx ? 18 : 16;
  const u16* Q = (const u16*)(p.ws + OFF_R1); const u16* K = (const u16*)(p.ws + OFF_R2); const u16* VT = (const u16*)(p.ws + OFF_R3);
  const u16* G = (const u16*)(p.ws + OFF_R4); u16* MG = (u16*)(p.ws + OFF_R0);
  float* rpbS = (float*)(smem + 65536 + 64);
  const char* Qs = smem + 32768;
  const int sw7 = (l15 >> 1) & 7;
  const int nitems = NB * 16 * RPI;
  const int ws = w == 0 ? 0 : (w == 1 ? 8 : (w == 2 ? 24 : 32));
  const int qc = 16 * w + l15;
  const int cs = min(max(qc - 8, 0), 48);
  const int d0 = ws + 4 * g - cs;
  const int bi0 = ws + 4 * g - qc + 15;
  const int kls = ((ws + l15) >> 1) & 7;
  const int kL0 = (ws + l15) * 128 + ((g ^ kls) << 4), kL1 = (ws + l15) * 128 + (((4 + g) ^ kls) << 4);
  const int kC0 = l15 * 128 + ((g ^ sw7) << 4), kC1 = l15 * 128 + (((4 + g) ^ sw7) << 4);
  const int vL0 = l15 * 128 + ((((ws >> 3) + (g >> 1)) ^ sw7) << 4) + (g & 1) * 8, vL1 = l15 * 128 + ((((ws >> 3) + 2 + (g >> 1)) ^ sw7) << 4) + (g & 1) * 8;
  const int vC0 = l15 * 128 + (((g >> 1) ^ sw7) << 4) + (g & 1) * 8, vC1 = l15 * 128 + (((2 + (g >> 1)) ^ sw7) << 4) + (g & 1) * 8;
  const int vC2 = l15 * 128 + (((4 + (g >> 1)) ^ sw7) << 4) + (g & 1) * 8, vC3 = l15 * 128 + (((6 + (g >> 1)) ^ sw7) << 4) + (g & 1) * 8;
  for (int it = cx.bid; it < nitems; it += cx.nblk) {
    const int rg = it % RPI, bh = it / RPI, h = bh & 15, b = bh >> 4;
    const bool lat = rg < 16;
    const int r0 = rg * 2;
    const int ylo = lat ? min(max(r0 - 4, 0), 24) : 0;
    const int yhi = lat ? min(max(r0 + 1 - 4, 0), 24) + 7 : -1;
    const int nloc = yhi - ylo + 1;
    const int nst = nloc + 4;
    const int mbase = b * LSEQ + (lat ? CTXL + r0 * 64 : (rg - 16) * 128);
    __syncthreads();
    for (int i = tid; i < 465; i += 256) rpbS[i] = p.na_rpb[((size_t)(layer >> 1) * 16 + h) * 465 + i] * 1.4426950408889634f;
#pragma unroll
    for (int i = 0; i < 4; ++i) {
      const int c = tid + 256 * i, qrow = c >> 3, ch = c & 7;
      u32x4 v = *(const u32x4*)(Q + (unsigned)((mbase + qrow) * 1024 + h * 64 + ch * 8));
      *(u32x4*)(smem + 32768 + qrow * 128 + ((ch ^ ((qrow >> 1) & 7)) << 4)) = v;
    }
    auto issue = [&](int st, int buf) {
      const int p0 = st < nloc ? CTXL + (ylo + st) * 64 : (st - nloc) * 64;
#pragma unroll
      for (int i = 0; i < 2; ++i) {
        const int row = w * 16 + i * 8 + (lane >> 3), ch = (lane & 7) ^ ((row >> 1) & 7);
        __builtin_amdgcn_global_load_lds((const unsigned*)(K + (unsigned)((b * LSEQ + p0 + row) * 1024 + h * 64 + ch * 8)), (unsigned*)(smem + buf * 16384 + w * 2048 + i * 1024 + lane * 16), 16, 0, 0);
        const int r32 = row & 31, vrow = (row & ~31) + 8 * ((r32 & 15) >> 2) + 4 * (r32 >> 4) + (r32 & 3);
        __builtin_amdgcn_global_load_lds((const unsigned*)(VT + (unsigned)((b * 1024 + h * 64 + vrow) * LSEQ + p0 + ch * 8)), (unsigned*)(smem + buf * 16384 + 8192 + w * 2048 + i * 1024 + lane * 16), 16, 0, 0);
      }
    };
    issue(0, 0);
    __syncthreads();
    float mrun[2], lrun[2];
    f32x4 o[2][4];
#pragma unroll
    for (int rr = 0; rr < 2; ++rr) {
      mrun[rr] = -1e20f; lrun[rr] = 0.f;
#pragma unroll
      for (int dt = 0; dt < 4; ++dt) o[rr][dt] = (f32x4){0.f, 0.f, 0.f, 0.f};
    }
    auto block = [&](const char* Ks, const char* Vs, int k0off, int k1off, int v0off, int v1off, bool local, int y, int ist, int ibuf) {
#pragma unroll
      for (int pr = 0; pr < 1; ++pr) {
        bf16x8 kf[2][2];
#pragma unroll
        for (int kt = 0; kt < 2; ++kt) { kf[kt][0] = *(const bf16x8*)(Ks + k0off + kt * 2048); kf[kt][1] = *(const bf16x8*)(Ks + k1off + kt * 2048); }
        if (ist >= 0) issue(ist, ibuf);
        f32x4 sc[2][2];
#pragma unroll
        for (int q2 = 0; q2 < 2; ++q2) {
          const int rr = 2 * pr + q2;
          const bf16x8 qf0 = *(const bf16x8*)(Qs + rr * 8192 + w * 2048 + kC0), qf1 = *(const bf16x8*)(Qs + rr * 8192 + w * 2048 + kC1);
          const int r = r0 + rr;
          const int rs = min(max(r - 4, 0), 24);
          const bool active = (y >= rs) && (y < rs + 8);
          float bv[8];
          if (local) {
            const float* bp = rpbS + ((y - r + 7) * 31 + bi0);
#pragma unroll
            for (int kt = 0; kt < 2; ++kt)
#pragma unroll
              for (int jj = 0; jj < 4; ++jj) bv[kt * 4 + jj] = bp[16 * kt + jj];
            asm volatile("" : "+v"(bv[0]), "+v"(bv[1]), "+v"(bv[2]), "+v"(bv[3]), "+v"(bv[4]), "+v"(bv[5]), "+v"(bv[6]), "+v"(bv[7]));
          }
#pragma unroll
          for (int kt = 0; kt < 2; ++kt) {
            sc[q2][kt] = mfma16(kf[kt][0], qf0, (f32x4){0.f, 0.f, 0.f, 0.f});
            sc[q2][kt] = mfma16(kf[kt][1], qf1, sc[q2][kt]);
          }
          if (local) {
#pragma unroll
            for (int kt = 0; kt < 2; ++kt)
#pragma unroll
              for (int jj = 0; jj < 4; ++jj) {
                const bool valid = active && ((unsigned)(d0 + 16 * kt + jj) < 16u);
                sc[q2][kt][jj] = valid ? sc[q2][kt][jj] + bv[kt * 4 + jj] : -1e30f;
              }
          }
        }
        float mx[2];
        bool need = false;
#pragma unroll
        for (int q2 = 0; q2 < 2; ++q2) {
          float m = fmaxf(fmaxf(fmaxf(sc[q2][0][0], sc[q2][0][1]), fmaxf(sc[q2][0][2], sc[q2][0][3])), fmaxf(fmaxf(sc[q2][1][0], sc[q2][1][1]), fmaxf(sc[q2][1][2], sc[q2][1][3])));
          mx[q2] = m; need = need || (m > mrun[2 * pr + q2] + 8.f);
        }
        if (__builtin_amdgcn_ballot_w64(need) != 0ull) {
#pragma unroll
          for (int q2 = 0; q2 < 2; ++q2) {
            const int rr = 2 * pr + q2;
            float m = mx[q2];
            m = fmaxf(m, __shfl_xor(m, 16)); m = fmaxf(m, __shfl_xor(m, 32));
            const float mnew = fmaxf(mrun[rr], m);
            const float alpha = __builtin_amdgcn_exp2f(mrun[rr] - mnew);
            mrun[rr] = mnew; lrun[rr] *= alpha;
#pragma unroll
            for (int dt = 0; dt < 4; ++dt) o[rr][dt] *= alpha;
          }
        }
        bf16x8 pfrag[2];
#pragma unroll
        for (int q2 = 0; q2 < 2; ++q2) {
          const int rr = 2 * pr + q2;
          const float mcur = mrun[rr];
          float ps = 0.f;
#pragma unroll
          for (int kt = 0; kt < 2; ++kt)
#pragma unroll
            for (int jj = 0; jj < 4; ++jj) { float e = __builtin_amdgcn_exp2f(sc[q2][kt][jj] - mcur); sc[q2][kt][jj] = e; ps += e; }
          lrun[rr] += ps;
          u32x4 p4 = {pk2(sc[q2][0][0], sc[q2][0][1]), pk2(sc[q2][0][2], sc[q2][0][3]), pk2(sc[q2][1][0], sc[q2][1][1]), pk2(sc[q2][1][2], sc[q2][1][3])};
          pfrag[q2] = __builtin_bit_cast(bf16x8, p4);
        }
#pragma unroll
        for (int dt = 0; dt < 4; ++dt) {
          u32x2 lo = *(const u32x2*)(Vs + v0off + dt * 2048);
          u32x2 hi = *(const u32x2*)(Vs + v1off + dt * 2048);
          u32x4 v4 = {lo[0], lo[1], hi[0], hi[1]};
          const bf16x8 vf = __builtin_bit_cast(bf16x8, v4);
#pragma unroll
          for (int q2 = 0; q2 < 2; ++q2) o[2 * pr + q2][dt] = mfma16(vf, pfrag[q2], o[2 * pr + q2][dt]);
        }
        __builtin_amdgcn_sched_barrier(0);
      }
    };
    for (int st = 0; st < nst; ++st) {
      const int buf = st & 1;
      const char* Ks = smem + buf * 16384; const char* Vs = Ks + 8192;
      const int ist = st + 1 < nst ? st + 1 : -1;
      if (st < nloc) {
        block(Ks, Vs, kL0, kL1, vL0, vL1, true, ylo + st, ist, buf ^ 1);
      } else {
        block(Ks, Vs, kC0, kC1, vC0, vC1, false, 0, ist, buf ^ 1);
        __builtin_amdgcn_sched_barrier(0);
        block(Ks, Vs, kC0 + 4096, kC1 + 4096, vC2, vC3, false, 0, -1, 0);
      }
      __syncthreads();
    }
#pragma unroll
    for (int rr = 0; rr < 2; ++rr) {
      float l = lrun[rr];
      l += __shfl_xor(l, 16); l += __shfl_xor(l, 32);
      const float inv = __builtin_amdgcn_rcpf(l);
#pragma unroll
      for (int dp = 0; dp < 2; ++dp) {
        const unsigned a = (unsigned)((mbase + rr * 64 + 16 * w + l15) * 1024 + h * 64 + dp * 32 + 8 * g);
        u32x4 gv = *(const u32x4*)(G + a);
        const f32x4 oa = o[rr][2 * dp] * inv, ob = o[rr][2 * dp + 1] * inv;
        u32x4 ov = {pk2(oa[0] * siluf(bf_lo(gv[0])), oa[1] * siluf(bf_hi(gv[0]))), pk2(oa[2] * siluf(bf_lo(gv[1])), oa[3] * siluf(bf_hi(gv[1]))),
                    pk2(ob[0] * siluf(bf_lo(gv[2])), ob[1] * siluf(bf_hi(gv[2]))), pk2(ob[2] * siluf(bf_lo(gv[3])), ob[3] * siluf(bf_hi(gv[3])))};
        *(u32x4*)(MG + a) = ov;
      }
    }
  }
}

#define XB_TMO      128
#define XB_XCNT(j)  (256  + 64 * (j))
#define XB_XSUB(j)  (1280 + 64 * (j))
#define XB_XGEN(j)  (2304 + 64 * (j))
#define XB_TOP      3328
#define XB_TOPGEN   3392
#define XCD_BAR_WORDS 3456
#define XB_SPIN_CAP (1u << 22)
#define LAS __attribute__((address_space(3)))
DI unsigned xb_ld(unsigned* p)              { return __hip_atomic_load(p, __ATOMIC_RELAXED, __HIP_MEMORY_SCOPE_AGENT); }
DI unsigned xb_add(unsigned* p, unsigned v) { return __hip_atomic_fetch_add(p, v, __ATOMIC_RELAXED, __HIP_MEMORY_SCOPE_AGENT); }
DI unsigned xb_xcc_id() { return (unsigned)__builtin_amdgcn_s_getreg((3 << 11) | 20) & 0xFu; }
#define XB_SPIN(cond, bar) do { unsigned _sp = 0; while (cond) { __builtin_amdgcn_s_sleep(1); \
    if ((++_sp & 255u) == 0u) { if (xb_ld(&(bar)[XB_TMO])) break; if (_sp > XB_SPIN_CAP) { atomicAdd(&(bar)[XB_TMO], 1u); break; } } } } while (0)
struct XcdBarrier { unsigned* bar; unsigned x; volatile LAS unsigned* st; };
DI XcdBarrier xcd_barrier_post(unsigned* bar, volatile LAS unsigned* st) {
  XcdBarrier b; b.bar = bar; b.x = xb_xcc_id(); b.st = st;
  if (threadIdx.x == 0) (void)xb_add(&bar[XB_XCNT(b.x)], 1u);
  return b;
}
DI void xcd_barrier_complete(unsigned* bar, unsigned x, unsigned& nloc, unsigned& nx) {
  const unsigned G = gridDim.x * gridDim.y * gridDim.z;
  unsigned sum, cnt, mine, sp = 0u;
  for (;;) {
    sum = 0u; cnt = 0u; mine = 0u;
#pragma unroll
    for (unsigned j = 0; j < 16; ++j) { const unsigned c = xb_ld(&bar[XB_XCNT(j)]); sum += c; cnt += (c > 0u) ? 1u : 0u; mine = (j == x) ? c : mine; }
    if (sum == G) break;
    __builtin_amdgcn_s_sleep(1);
    if ((++sp & 255u) == 0u) { if (xb_ld(&bar[XB_TMO])) break; if (sp > XB_SPIN_CAP) { atomicAdd(&bar[XB_TMO], 1u); break; } }
  }
  nloc = mine > 0u ? mine : 1u; nx = cnt > 0u ? cnt : 1u;
}
DI void xcd_barrier(const XcdBarrier& b) {
  asm volatile("s_waitcnt vmcnt(0)" ::: "memory");
  __syncthreads();
  if (threadIdx.x == 0) {
    unsigned* bar = b.bar;
    __builtin_amdgcn_s_waitcnt(0);
    unsigned nloc = b.st[0], nx = b.st[1];
    if (nloc == 0u) { xcd_barrier_complete(bar, b.x, nloc, nx); b.st[0] = nloc; b.st[1] = nx; }
    const unsigned old = xb_add(&bar[XB_XSUB(b.x)], 1u);
    const unsigned gen = old / nloc;
    if (old + 1u == (gen + 1u) * nloc) {
      __builtin_amdgcn_fence(__ATOMIC_RELEASE, "agent");
      asm volatile("s_waitcnt vmcnt(0)" ::: "memory");
      const unsigned og = xb_add(&bar[XB_TOP], 1u);
      const unsigned tg = og / nx;
      if (og + 1u == (tg + 1u) * nx) xb_add(&bar[XB_TOPGEN], 1u);
      else XB_SPIN(xb_ld(&bar[XB_TOPGEN]) == tg, bar);
      __builtin_amdgcn_fence(__ATOMIC_ACQUIRE, "agent");
      xb_add(&bar[XB_XGEN(b.x)], 1u);
      asm volatile("s_waitcnt vmcnt(0)" ::: "memory");
    } else {
      XB_SPIN(xb_ld(&bar[XB_XGEN(b.x)]) == gen, bar);
      __builtin_amdgcn_fence(__ATOMIC_ACQUIRE, "agent");
      asm volatile("s_waitcnt vmcnt(0)" ::: "memory");
    }
  }
  __syncthreads();
}

constexpr int NPHASES = 22;
constexpr int SMEM_BYTES = 79872;
__global__ void __launch_bounds__(256, 2) fwd_megakernel(Params p) {
  __shared__ __attribute__((aligned(16))) char smem[SMEM_BYTES];
  cg::grid_group grid = cg::this_grid();
  __shared__ uint4 xb_words;
  if (threadIdx.x == 0) xb_words = make_uint4(0u, 0u, 0u, 0u);
  __syncthreads();
  XcdBarrier xb = xcd_barrier_post((unsigned*)(p.ws + OFF_BAR), (volatile LAS unsigned*)&xb_words);
  const int wave_id = __builtin_amdgcn_readfirstlane((int)(threadIdx.x >> 6));
  for (int ph = p.ph_lo; ph < p.ph_hi; ++ph) {
    Ctx cx; cx.tid = wave_id * 64 + (int)__builtin_amdgcn_mbcnt_hi(~0u, __builtin_amdgcn_mbcnt_lo(~0u, 0u)); cx.bid = blockIdx.x; cx.nblk = gridDim.x;
    asm volatile("" : "+v"(cx.tid)); asm volatile("" : "+s"(cx.bid)); asm volatile("" : "+s"(cx.nblk));
    Params pp = p;
    asm volatile("" : "+s"(pp.ws)); asm volatile("" : "+s"(pp.out));
    if (ph == 0) phase0a(cx, pp, smem);
    else if (ph == 1) phase0b(cx, pp);
    else {
      const int q = ph - 2, pair = q / 10, r = q % 10;
      const int layer = 2 * pair + (r >= 6 ? 1 : 0);
      int gk = -1;
      if (r == 0) gk = 0; else if (r == 6) gk = 1; else if (r == 4 || r == 8) gk = 2;
      asm volatile("" : "+s"(gk));
      if (gk >= 0) { for (int rep = 0; rep < (gk == 2 ? REP_GOUT : REP_GIN); ++rep) gemm_phase(cx, pp, gk, layer, smem); }
      else if (r == 5 || r == 9) ln_phase(cx, pp, layer, smem);
      else if (r == 1) { for (int rep = 0; rep < REP_PREP; ++rep) gla_prep_phase(cx, pp, layer, smem); }
      else if (r == 2) { for (int rep = 0; rep < REP_CHAIN; ++rep) gla_chain_phase(cx, pp, smem); }
      else if (r == 3) gla_merge_phase(cx, pp, layer);
      else { for (int rep = 0; rep < REP_NA; ++rep) na_attn_phase(cx, pp, layer, smem); }
    }
    if (ph + 1 < p.ph_hi) { if (p.ph_hi > NPHASES) grid.sync(); else xcd_barrier(xb); }
  }
}

extern "C" void kernel_launch(void* const* d_in, const int* in_sizes, int n_in, void* d_out, int out_size, void* d_ws, size_t ws_size, hipStream_t stream) {
  static int grid_blocks = 0;
  if (!grid_blocks) {
    int dev = 0, cus = 0, per_cu = 0;
    hipGetDevice(&dev);
    hipDeviceGetAttribute(&cus, hipDeviceAttributeMultiprocessorCount, dev);
    hipOccupancyMaxActiveBlocksPerMultiprocessor(&per_cu, fwd_megakernel, 256, 0);
    if (per_cu > 2) per_cu = 2;
    grid_blocks = cus * per_cu;
    if (grid_blocks <= 0 || (grid_blocks & 7)) grid_blocks = -1;
  }
  if (grid_blocks < 0 || ws_size < WS_END || n_in < 16) return;
  Params p{};
  p.x = (const float*)d_in[0]; p.c = (const float*)d_in[1]; p.ctx = (const float*)d_in[2]; p.c_ctx = (const float*)d_in[3];
  p.ada_w = (const float*)d_in[4]; p.ada_b = (const float*)d_in[5]; p.ln_g = (const float*)d_in[6]; p.ln_b = (const float*)d_in[7];
  p.w_out = (const float*)d_in[8]; p.gla_w_in = (const float*)d_in[9]; p.gla_dec_w1 = (const float*)d_in[10]; p.gla_dec_w2 = (const float*)d_in[11];
  p.gla_dec_b = (const float*)d_in[12]; p.gla_norm_g = (const float*)d_in[13]; p.na_w_in = (const float*)d_in[14]; p.na_rpb = (const float*)d_in[15];
  p.out = (float*)d_out; p.ws = (unsigned char*)d_ws;
#if MULTI_LAUNCH
  for (int ph = 0; ph < NPHASES; ++ph) {
    p.ph_lo = ph; p.ph_hi = ph + 1;
    hipLaunchKernelGGL(fwd_megakernel, dim3(grid_blocks), dim3(256), 0, stream, p);
  }
#else
  p.ph_lo = 0; p.ph_hi = NPHASES;
  hipMemsetAsync((char*)d_ws + OFF_BAR, 0, 3456 * 4, stream);
  void* args[] = {&p};
  hipLaunchCooperativeKernel((void*)fwd_megakernel, dim3(grid_blocks), dim3(256), args, 0, stream);
#endif
}
```

```cpp
#include <hip/hip_runtime.h>
#include <hip/hip_cooperative_groups.h>
namespace cg = cooperative_groups;

#define REP_GIN 1
#define REP_GOUT 1
#define REP_PREP 1
#define REP_CHAIN 1
#define REP_NA 1
#ifndef MULTI_LAUNCH
#define MULTI_LAUNCH 0
#endif

#define DI __device__ __forceinline__
typedef short bf16x8 __attribute__((ext_vector_type(8)));
typedef float f32x4 __attribute__((ext_vector_type(4)));
typedef float f32x2 __attribute__((ext_vector_type(2)));
typedef unsigned u32x4 __attribute__((ext_vector_type(4)));
typedef unsigned u32x2 __attribute__((ext_vector_type(2)));
typedef __bf16 bf2 __attribute__((ext_vector_type(2)));
typedef unsigned short u16;

DI unsigned pk2(float lo, float hi) { f32x2 v = {lo, hi}; bf2 b = __builtin_convertvector(v, bf2); return __builtin_bit_cast(unsigned, b); }
DI float bf_lo(unsigned u) { return __uint_as_float(u << 16); }
DI float bf_hi(unsigned u) { return __uint_as_float(u & 0xffff0000u); }
DI float bf2f(u16 h) { return __uint_as_float(((unsigned)h) << 16); }
DI u16 f2bf(float f) { return (u16)(pk2(f, 0.f) & 0xffffu); }
DI f32x4 mfma16(bf16x8 a, bf16x8 b, f32x4 c) { return __builtin_amdgcn_mfma_f32_16x16x32_bf16(a, b, c, 0, 0, 0); }
DI float siluf(float x) { return x * __builtin_amdgcn_rcpf(1.f + __expf(-x)); }

constexpr int D = 1024, NB = 8, SEQ = 2048, CTXL = 256, LSEQ = 2304, MROWS = NB * LSEQ;
constexpr int NCHUNK = 36;
constexpr size_t MiB = 1u << 20;
constexpr size_t U = 36 * MiB;
constexpr size_t OFF_R0 = 0, OFF_R1 = U, OFF_R2 = 2 * U, OFF_R3 = 3 * U, OFF_R4 = 4 * U, OFF_R5 = 5 * U, OFF_R6 = 6 * U;
constexpr size_t OFF_XCTX = 234 * MiB, OFF_WIN = 242 * MiB, OFF_WOUT = 250 * MiB, OFF_LOW = 252 * MiB;
constexpr size_t OFF_DEC = OFF_LOW + (size_t)MROWS * 32 * 2;
constexpr size_t OFF_MOD = OFF_DEC + (size_t)2304 * 128 * 4;
constexpr size_t OFF_ROPE = OFF_MOD + (size_t)4 * 9 * 3072 * 4;
constexpr size_t OFF_BAR = OFF_ROPE + (size_t)2 * 64 * 32 * 4;
constexpr size_t WS_END = OFF_BAR + 3456 * 4;
constexpr float ALPHA = 1.681792830507429f;

struct Ctx { int tid, bid, nblk; };
struct Params {
  const float *x, *c, *ctx, *c_ctx, *ada_w, *ada_b, *ln_g, *ln_b, *w_out, *gla_w_in, *gla_dec_w1, *gla_dec_w2, *gla_dec_b, *gla_norm_g, *na_w_in, *na_rpb;
  float* out; unsigned char* ws; int ph_lo, ph_hi;
};

DI void transpose_tile(const Ctx& cx, const float* __restrict__ src, int N, u16* __restrict__ dst, int k0, int n0, char* smem) {
  float* t = (float*)smem;
  const int tid = cx.tid;
  __syncthreads();
#pragma unroll
  for (int i = 0; i < 4; ++i) {
    int k = (tid >> 4) + 16 * i, n4 = (tid & 15) * 4;
    f32x4 v = *(const f32x4*)(src + (size_t)(k0 + k) * N + n0 + n4);
    t[k * 65 + n4] = v[0]; t[k * 65 + n4 + 1] = v[1]; t[k * 65 + n4 + 2] = v[2]; t[k * 65 + n4 + 3] = v[3];
  }
  __syncthreads();
#pragma unroll
  for (int j = 0; j < 2; ++j) {
    int c = tid + 256 * j, n = c >> 3, kc = (c & 7) * 8;
    u32x4 o;
    o[0] = pk2(t[(kc + 0) * 65 + n], t[(kc + 1) * 65 + n]); o[1] = pk2(t[(kc + 2) * 65 + n], t[(kc + 3) * 65 + n]);
    o[2] = pk2(t[(kc + 4) * 65 + n], t[(kc + 5) * 65 + n]); o[3] = pk2(t[(kc + 6) * 65 + n], t[(kc + 7) * 65 + n]);
    *(u32x4*)(dst + (size_t)(n0 + n) * 1024 + k0 + kc) = o;
  }
}

DI int convert_items(int layer) { return (layer & 1) ? (16 * 64 + 256) : (16 * 48 + 16 + 256); }
DI void convert_item(const Ctx& cx, const Params& p, int layer, int it, char* smem) {
  u16* win = (u16*)(p.ws + OFF_WIN); u16* wout = (u16*)(p.ws + OFF_WOUT);
  const int j = layer >> 1;
  if (layer & 1) {
    if (it < 1024) { transpose_tile(cx, p.na_w_in + (size_t)j * 1024 * 4096, 4096, win, (it >> 6) * 64, (it & 63) * 64, smem); return; }
    it -= 1024;
  } else {
    if (it < 768) { transpose_tile(cx, p.gla_w_in + (size_t)j * 1024 * 3072, 3072, win, (it / 48) * 64, (it % 48) * 64, smem); return; }
    it -= 768;
    if (it < 16) {
      const float* w1 = p.gla_dec_w1 + (size_t)j * 2 * 1024 * 16;
#pragma unroll 4
      for (int idx = cx.tid; idx < 8 * 1024; idx += 256) {
        int row = it * 8 + (idx >> 10), k = idx & 1023;
        float v = row < 32 ? w1[((size_t)(row >> 4) * 1024 + k) * 16 + (row & 15)] : 0.f;
        win[(size_t)(3072 + row) * 1024 + k] = f2bf(v);
      }
      return;
    }
    it -= 16;
  }
  transpose_tile(cx, p.w_out + (size_t)layer * 1024 * 1024, 1024, wout, (it >> 4) * 64, (it & 15) * 64, smem);
}

DI void phase0a(const Ctx& cx, const Params& p, char* smem) {
  const int tid = cx.tid;
  float* mod = (float*)(p.ws + OFF_MOD);
  const int nconv = convert_items(0);
  const int nitems = 384 + nconv + 1;
  bool sc_ready = false;
  float* sc = (float*)smem;
  float* red = (float*)(smem + 36864);
  for (int it = cx.bid; it < nitems; it += cx.nblk) {
    if (it < 384) {
      if (!sc_ready) {
        {
          float cv[36];
#pragma unroll
          for (int u = 0; u < 32; ++u) cv[u] = p.c[tid + 256 * u];
#pragma unroll
          for (int u = 0; u < 4; ++u) cv[32 + u] = p.c_ctx[tid + 256 * u];
#pragma unroll
          for (int u = 0; u < 36; ++u) sc[tid + 256 * u] = siluf(cv[u]);
        }
        sc_ready = true;
      }
      __syncthreads();
      const int layer = it / 96, col0 = (it % 96) * 32;
      const int c4 = tid & 7, kg = tid >> 3;
      const float* W = p.ada_w + (size_t)layer * 1024 * 3072 + col0 + c4 * 4;
      f32x4 acc[9];
#pragma unroll
      for (int c = 0; c < 9; ++c) acc[c] = (f32x4){0.f, 0.f, 0.f, 0.f};
      for (int i0 = 0; i0 < 32; i0 += 8) {
        f32x4 wv[8];
#pragma unroll
        for (int u = 0; u < 8; ++u) wv[u] = *(const f32x4*)(W + (size_t)(kg + 32 * (i0 + u)) * 3072);
#pragma unroll
        for (int u = 0; u < 8; ++u) {
          const int k = kg + 32 * (i0 + u);
#pragma unroll
          for (int c = 0; c < 9; ++c) { float s2 = sc[c * 1024 + k]; acc[c] += wv[u] * s2; }
        }
      }
#pragma unroll
      for (int c = 0; c < 9; ++c)
#pragma unroll
        for (int e = 0; e < 4; ++e) { float v = acc[c][e]; v += __shfl_xor(v, 8); v += __shfl_xor(v, 16); v += __shfl_xor(v, 32); acc[c][e] = v; }
      const int w = tid >> 6, lane = tid & 63;
      if (lane < 8) {
#pragma unroll
        for (int c = 0; c < 9; ++c)
#pragma unroll
          for (int e = 0; e < 4; ++e) red[(w * 9 + c) * 32 + lane * 4 + e] = acc[c][e];
      }
      __syncthreads();
      for (int o = tid; o < 9 * 32; o += 256) {
        int c = o >> 5, col = o & 31;
        float v = red[(0 * 9 + c) * 32 + col] + red[(1 * 9 + c) * 32 + col] + red[(2 * 9 + c) * 32 + col] + red[(3 * 9 + c) * 32 + col];
        v += p.ada_b[layer * 3072 + col0 + col];
        mod[((size_t)layer * 9 + c) * 3072 + col0 + col] = v;
      }
      __syncthreads();
    } else if (it < 384 + nconv) {
      __syncthreads();
      sc_ready = false;
      convert_item(cx, p, 0, it - 384, smem);
    } else {
      float* rc = (float*)(p.ws + OFF_ROPE); float* rs = rc + 2048;
      for (int i = tid; i < 2048; i += 256) {
        int pos = i >> 5, q = i & 31;
        float inv = __builtin_amdgcn_exp2f(-(float)q * (13.287712379549449f / 32.f));
        float rev = (float)pos * inv * 0.15915494309189535f;
        rc[i] = __builtin_amdgcn_cosf(rev); rs[i] = __builtin_amdgcn_sinf(rev);
      }
    }
  }
}

DI const float* resid_in(const Params& p, int layer, int b, int pos) {
  if (pos < CTXL) return (layer == 0 ? p.ctx : (const float*)(p.ws + OFF_XCTX)) + ((size_t)b * CTXL + pos) * D;
  return (layer == 0 ? p.x : (const float*)p.out) + ((size_t)b * SEQ + (pos - CTXL)) * D;
}
DI float* resid_out(const Params& p, int b, int pos) {
  if (pos < CTXL) return (float*)(p.ws + OFF_XCTX) + ((size_t)b * CTXL + pos) * D;
  return p.out + ((size_t)b * SEQ + (pos - CTXL)) * D;
}

DI void phase0b(const Ctx& cx, const Params& p) {
  const int lane = cx.tid & 63, wg = (cx.bid * 256 + cx.tid) >> 6, nw = cx.nblk * 4;
  const float* mod = (const float*)(p.ws + OFF_MOD);
  u16* H = (u16*)(p.ws + OFF_R0);
  for (int m0 = wg; m0 < MROWS; m0 += 2 * nw) {
    f32x4 xv[2][4], sh[2][4], sc[2][4];
#pragma unroll
    for (int q = 0; q < 2; ++q) {
      const int m = m0 + q * nw;
      if (m < MROWS) {
        const int b = m / LSEQ, pos = m % LSEQ;
        const float* xr = resid_in(p, 0, b, pos);
        const float* md = mod + (size_t)(0 * 9 + (pos < CTXL ? 8 : b)) * 3072;
#pragma unroll
        for (int i = 0; i < 4; ++i) { const int c = 4 * lane + 256 * i; xv[q][i] = *(const f32x4*)(xr + c); sh[q][i] = *(const f32x4*)(md + c); sc[q][i] = *(const f32x4*)(md + 1024 + c); }
      }
    }
#pragma unroll
    for (int q = 0; q < 2; ++q) {
      const int m = m0 + q * nw;
      if (m >= MROWS) continue;
#pragma unroll
      for (int i = 0; i < 4; ++i) {
        const int c = 4 * lane + 256 * i;
        f32x4 h = xv[q][i] * (sc[q][i] + 1.f) + sh[q][i];
        u32x2 o = {pk2(h[0], h[1]), pk2(h[2], h[3])};
        *(u32x2*)(H + (size_t)m * D + c) = o;
      }
    }
  }
}

DI void gemm_tile(const Ctx& cx, const u16* __restrict__ A, const u16* __restrict__ Bt, int row0, int col0, char* smem, f32x4 (&acc)[4][8]) {
  const int tid = cx.tid, lane = tid & 63, w = tid >> 6, wm = w >> 1, wn = w & 1, l15 = lane & 15, g = lane >> 4;
  const char* Abase = (const char*)(A + (size_t)row0 * 1024);
  const char* Bbase = (const char*)(Bt + (size_t)col0 * 1024);
  unsigned voA[4], voB[2];
#pragma unroll
  for (int i = 0; i < 4; ++i) { const int row = w * 64 + i * 16 + (lane >> 2), ch = (lane & 3) ^ ((-(row >> 2)) & 3); voA[i] = (unsigned)(row * 2048 + ch * 16); }
#pragma unroll
  for (int i = 0; i < 2; ++i) {
    const int row = w * 32 + i * 16 + (lane >> 2), ch = (lane & 3) ^ ((-(row >> 2)) & 3);
    const int r32 = row & 31, grow = (row & ~31) + 8 * ((r32 & 15) >> 2) + 4 * (r32 >> 4) + (r32 & 3);
    voB[i] = (unsigned)(grow * 2048 + ch * 16); }
  const int lA = w * 4096 + lane * 16, lB = 16384 + w * 2048 + lane * 16;
  const unsigned fo = (unsigned)(size_t)smem + l15 * 64 + ((g ^ ((-(l15 >> 2)) & 3)) << 4);
  const unsigned xbase = fo + 16384 + wn * 4096, ybase = fo + wm * 8192;
#pragma unroll
  for (int i = 0; i < 4; ++i)
#pragma unroll
    for (int j = 0; j < 8; ++j) acc[i][j] = (f32x4){0.f, 0.f, 0.f, 0.f};
#define GL_STAGE(kt_, so_) do { const char* ak_ = Abase + (kt_) * 64; const char* bk_ = Bbase + (kt_) * 64; char* sb_ = smem + (so_); \
    _Pragma("unroll") for (int i = 0; i < 4; ++i) { asm volatile("" : "+v"(voA[i]));   \
      __builtin_amdgcn_global_load_lds((const unsigned*)(ak_ + voA[i]), (unsigned*)(sb_ + lA + i * 1024), 16, 0, 0); } \
    _Pragma("unroll") for (int i = 0; i < 2; ++i) { asm volatile("" : "+v"(voB[i])); \
      __builtin_amdgcn_global_load_lds((const unsigned*)(bk_ + voB[i]), (unsigned*)(sb_ + lB + i * 1024), 16, 0, 0); } } while (0)
#define GL_STAGE_A(kt_, so_) do { const char* ak_ = Abase + (kt_) * 64; char* sb_ = smem + (so_); \
    _Pragma("unroll") for (int i = 0; i < 4; ++i) { asm volatile("" : "+v"(voA[i])); \
      __builtin_amdgcn_global_load_lds((const unsigned*)(ak_ + voA[i]), (unsigned*)(sb_ + lA + i * 1024), 16, 0, 0); } } while (0)
#define GL_STAGE_B(kt_, so_) do { const char* bk_ = Bbase + (kt_) * 64; char* sb_ = smem + (so_); \
    _Pragma("unroll") for (int i = 0; i < 2; ++i) { asm volatile("" : "+v"(voB[i])); \
      __builtin_amdgcn_global_load_lds((const unsigned*)(bk_ + voB[i]), (unsigned*)(sb_ + lB + i * 1024), 16, 0, 0); } } while (0)
#define DS_RD(dst, addr, off) asm volatile("ds_read_b128 %0, %1 offset:%2" : "=v"(dst) : "v"(addr), "n"(off))
  GL_STAGE(0, 0); GL_STAGE(1, 24576);
  if (cx.bid & 256) __builtin_amdgcn_s_sleep(10);
  int sc = 0;
  for (int kt = 0; kt < 32; ++kt) {
    if (kt < 31) asm volatile("s_waitcnt vmcnt(6)" ::: "memory");
    else asm volatile("s_waitcnt vmcnt(0)" ::: "memory");
    __builtin_amdgcn_s_barrier();
    const int sn = sc == 0 ? 49152 : sc - 24576;
    const unsigned xa = xbase + sc, ya = ybase + sc;
    bf16x8 xf[4], yf[8];
    DS_RD(xf[0], xa, 0); DS_RD(xf[1], xa, 1024); DS_RD(xf[2], xa, 2048); DS_RD(xf[3], xa, 3072);
    DS_RD(yf[0], ya, 0); DS_RD(yf[1], ya, 1024); DS_RD(yf[2], ya, 2048); DS_RD(yf[3], ya, 3072);
    DS_RD(yf[4], ya, 4096); DS_RD(yf[5], ya, 5120); DS_RD(yf[6], ya, 6144); DS_RD(yf[7], ya, 7168);
    if (kt + 2 < 32) GL_STAGE_A(kt + 2, sn);
    asm volatile("s_waitcnt lgkmcnt(4)" : "+v"(xf[0]), "+v"(xf[1]), "+v"(xf[2]), "+v"(xf[3]), "+v"(yf[0]), "+v"(yf[1]), "+v"(yf[2]), "+v"(yf[3]) :: "memory");
    __builtin_amdgcn_sched_barrier(0);
#pragma unroll
    for (int i = 0; i < 4; ++i)
#pragma unroll
      for (int j = 0; j < 4; ++j) acc[i][j] = mfma16(xf[i], yf[j], acc[i][j]);
    __builtin_amdgcn_sched_barrier(0);
    if (kt + 2 < 32) GL_STAGE_B(kt + 2, sn);
    asm volatile("s_waitcnt lgkmcnt(0)" : "+v"(yf[4]), "+v"(yf[5]), "+v"(yf[6]), "+v"(yf[7]) :: "memory");
    __builtin_amdgcn_sched_barrier(0);
#pragma unroll
    for (int i = 0; i < 4; ++i)
#pragma unroll
      for (int j = 4; j < 8; ++j) acc[i][j] = mfma16(xf[i], yf[j], acc[i][j]);
    __builtin_amdgcn_sched_barrier(0);
    sc = sc == 49152 ? 0 : sc + 24576;
  }
#undef GL_STAGE
#undef GL_STAGE_A
#undef GL_STAGE_B
#undef DS_RD
  __builtin_amdgcn_s_barrier();
}

DI void store_T(const Ctx& cx, const f32x4 (&acc)[4][8], u16* dst, int ld, int row0, int fcol0, float scale, char* smem) {
  const int lane = cx.tid & 63, w = cx.tid >> 6, wm = w >> 1, wn = w & 1, l15 = lane & 15, g = lane >> 4;
  char* img = smem + w * 18432;
#pragma unroll
  for (int yj = 0; yj < 8; ++yj)
#pragma unroll
    for (int xp = 0; xp < 2; ++xp) {
      f32x4 v0 = acc[2 * xp][yj] * scale, v1 = acc[2 * xp + 1][yj] * scale;
      u32x4 o = {pk2(v0[0], v0[1]), pk2(v0[2], v0[3]), pk2(v1[0], v1[1]), pk2(v1[2], v1[3])};
      *(u32x4*)(img + (yj * 16 + l15) * 144 + xp * 64 + 16 * g) = o;
    }
  __builtin_amdgcn_fence(__ATOMIC_RELEASE, "wavefront");
  asm volatile("s_waitcnt lgkmcnt(0)" ::: "memory");
  char* base = (char*)(dst + (size_t)(row0 + wm * 128) * ld + fcol0 + wn * 64) + (lane & 7) * 16;
  const int tr = lane >> 3;
#pragma unroll
  for (int k = 0; k < 16; ++k) {
    const int t = 8 * k + tr;
    u32x4 v = *(const u32x4*)(img + t * 144 + (lane & 7) * 16);
    *(u32x4*)(base + (size_t)((unsigned)(t * ld) * 2u)) = v;
  }
  __syncthreads();
}
DI void store_VT(const Ctx& cx, const f32x4 (&acc)[4][8], u16* vt, int b, int pos0, int fcol0, char* smem) {
  const int tid = cx.tid, lane = tid & 63, w = tid >> 6, wm = w >> 1, wn = w & 1, l15 = lane & 15, g = lane >> 4;
#pragma unroll
  for (int xi = 0; xi < 4; ++xi)
#pragma unroll
    for (int yj = 0; yj < 8; ++yj) {
      const unsigned p01 = pk2(acc[xi][yj][0], acc[xi][yj][1]), p23 = pk2(acc[xi][yj][2], acc[xi][yj][3]);
      const int f = wn * 64 + (xi >> 1) * 32 + 8 * g + 4 * (xi & 1), t = wm * 128 + yj * 16 + l15;
      char* d = smem + f * 528 + t * 2;
      *(u16*)(d) = (u16)(p01 & 0xffffu); *(u16*)(d + 528) = (u16)(p01 >> 16);
      *(u16*)(d + 1056) = (u16)(p23 & 0xffffu); *(u16*)(d + 1584) = (u16)(p23 >> 16);
    }
  __syncthreads();
#pragma unroll
  for (int i = 0; i < 16; ++i) {
    const int c = tid + 256 * i, f = c >> 5, tc = c & 31;
    u32x4 v = *(const u32x4*)(smem + f * 528 + tc * 16);
    *(u32x4*)(vt + (size_t)((unsigned)((b * 1024 + fcol0 + f) * LSEQ + pos0 + tc * 8))) = v;
  }
  __syncthreads();
}

DI void gemm_phase(const Ctx& cx, const Params& p, int kind, int layer, char* smem) {
  const int NC = kind == 0 ? 25 : (kind == 1 ? 32 : 8);
  const u16* A = (const u16*)(p.ws + OFF_R0);
  const u16* Bt = (const u16*)(p.ws + (kind == 2 ? OFF_WOUT : OFF_WIN));
  const bool last = (layer == 3);
  const int nitems = 72 * NC;
  for (int it = cx.bid; it < nitems; it += cx.nblk) {
    const int xcd = it & 7, j = it >> 3;
    const int grp = j / 72, rem = j - grp * 72, gw = min(8, NC - grp * 8);
    const int rt = (rem / gw) * 8 + xcd, ct = grp * 8 + rem % gw;
    const int b = rt / 9, pos0 = (rt % 9) * 256, row0 = rt * 256, col0 = ct * 128;
    const bool isctx = pos0 < CTXL;
    if (kind == 1) { if (last && isctx && (ct < 8 || ct >= 24)) continue; }
    else if (kind == 2) { if (last && isctx) continue; }
    f32x4 acc[4][8];
    gemm_tile(cx, A, Bt, row0, col0, smem, acc);
    Ctx cx2 = cx; asm volatile("" : "+v"(cx2.tid));
    if (kind == 0) {
      if (ct < 8) store_T(cx2, acc, (u16*)(p.ws + OFF_R1), 1024, row0, col0, ct < 4 ? 0.08838834764831845f : 1.f, smem);
      else if (ct < 16) store_VT(cx2, acc, (u16*)(p.ws + OFF_R3), b, pos0, col0 - 1024, smem);
      else if (ct < 24) store_T(cx2, acc, (u16*)(p.ws + OFF_R4), 1024, row0, col0 - 2048, 1.f, smem);
      else {
        const int lane = cx2.tid & 63, w = cx2.tid >> 6, wm = w >> 1, wn = w & 1, l15 = lane & 15, g = lane >> 4;
        u16* low = (u16*)(p.ws + OFF_LOW);
        if (wn == 0) {
#pragma unroll
          for (int yj = 0; yj < 8; ++yj) {
            const unsigned token = row0 + wm * 128 + yj * 16 + l15;
            f32x4 v0 = acc[0][yj], v1 = acc[1][yj];
            u32x4 o = {pk2(v0[0], v0[1]), pk2(v0[2], v0[3]), pk2(v1[0], v1[1]), pk2(v1[2], v1[3])};
            *(u32x4*)(low + (size_t)(token * 32u + 8 * g)) = o;
          }
        }
      }
    } else if (kind == 1) {
      if (ct < 8) store_T(cx2, acc, (u16*)(p.ws + OFF_R1), 1024, row0, col0, 0.125f * 1.4426950408889634f, smem);
      else if (ct < 16) store_T(cx2, acc, (u16*)(p.ws + OFF_R2), 1024, row0, col0 - 1024, 1.f, smem);
      else if (ct < 24) store_VT(cx2, acc, (u16*)(p.ws + OFF_R3), b, pos0, col0 - 2048, smem);
      else store_T(cx2, acc, (u16*)(p.ws + OFF_R4), 1024, row0, col0 - 3072, 1.f, smem);
    } else {
      store_T(cx2, acc, (u16*)(p.ws + OFF_R2), 1024, row0, col0, 1.f, smem);
    }
  }
}

DI void gla_prep_phase(const Ctx& cx, const Params& p, int layer, char* smem) {
  const int tid = cx.tid, lane = tid & 63, w = tid >> 6, l15 = lane & 15, g = lane >> 4;
  const int jl = layer >> 1;
  char* qS = smem; char* kS = smem + 16384;
  float* lowS = (float*)(smem + 32768);
  float* totS = (float*)(smem + 32768 + 4096);
  const u16* QK = (const u16*)(p.ws + OFF_R1);
  const u16* LOW = (const u16*)(p.ws + OFF_LOW);
  u16* QT = (u16*)(p.ws + OFF_R2); u16* KE = (u16*)(p.ws + OFF_R5); u16* ATT = (u16*)(p.ws + OFF_R6);
  float* DEC = (float*)(p.ws + OFF_DEC);
  const float* ropeC = (const float*)(p.ws + OFF_ROPE); const float* ropeS = ropeC + 2048;
  const int d6 = tid & 63, tq = tid >> 6;
  float* ropeL = (float*)(smem + 40960);
  {
    u32x4 rv[4];
#pragma unroll
    for (int u = 0; u < 4; ++u) rv[u] = *(const u32x4*)(ropeC + (tid + 256 * u) * 4);
#pragma unroll
    for (int u = 0; u < 4; ++u) *(u32x4*)(ropeL + (tid + 256 * u) * 4) = rv[u];
  }
  for (int it = cx.bid; it < NB * NCHUNK * 8; it += cx.nblk) {
    const int dir = it & 1, h = (it >> 1) & 3, bn = it >> 3, n = bn % NCHUNK, b = bn / NCHUNK;
    const size_t m0 = (size_t)b * LSEQ + n * 64;
    __syncthreads();
#pragma unroll
    for (int i = 0; i < 4; ++i) {
      int c = tid + 256 * i, row = c >> 4, ch = c & 15;
      u32x4 vq = *(const u32x4*)(QK + (m0 + row) * 1024 + h * 128 + ch * 8);
      u32x4 vk = *(const u32x4*)(QK + (m0 + row) * 1024 + 512 + h * 128 + ch * 8);
      int o = row * 256 + ((ch ^ (row & 15)) << 4);
      *(u32x4*)(qS + o) = vq; *(u32x4*)(kS + o) = vk;
    }
#pragma unroll
    for (int i = 0; i < 4; ++i) {
      int idx = tid + 256 * i, t = idx >> 4, r = idx & 15;
      lowS[idx] = bf2f(LOW[(m0 + t) * 32 + dir * 16 + r]);
    }
    float w2a[16], w2b[16];
    const float* w2 = p.gla_dec_w2 + ((size_t)(jl * 2 + dir) * 16) * 512 + h * 128 + d6;
#pragma unroll
    for (int r = 0; r < 16; ++r) { w2a[r] = w2[r * 512]; w2b[r] = w2[r * 512 + 64]; }
    const float ba = p.gla_dec_b[(jl * 2 + dir) * 512 + h * 128 + d6], bb = p.gla_dec_b[(jl * 2 + dir) * 512 + h * 128 + d6 + 64];
    __syncthreads();
    float la0[16], la1[16];
    float s0 = 0.f, s1 = 0.f;
#pragma unroll
    for (int tt = 0; tt < 16; ++tt) {
      const int t = tq * 16 + tt;
      float x0 = ba, x1 = bb;
#pragma unroll
      for (int r4 = 0; r4 < 4; ++r4) {
        f32x4 lv = *(const f32x4*)(lowS + t * 16 + r4 * 4);
#pragma unroll
        for (int e = 0; e < 4; ++e) { x0 += lv[e] * w2a[r4 * 4 + e]; x1 += lv[e] * w2b[r4 * 4 + e]; }
      }
      float l0 = (fminf(x0, 0.f) - __logf(1.f + __expf(-fabsf(x0)))) * 0.0625f;
      float l1 = (fminf(x1, 0.f) - __logf(1.f + __expf(-fabsf(x1)))) * 0.0625f;
      la0[tt] = l0; la1[tt] = l1; s0 += l0; s1 += l1;
    }
    totS[tq * 128 + d6] = s0; totS[tq * 128 + d6 + 64] = s1;
    __syncthreads();
    float off0 = 0.f, off1 = 0.f, tot0 = 0.f, tot1 = 0.f;
#pragma unroll
    for (int q = 0; q < 4; ++q) {
      float a = totS[q * 128 + d6], bq = totS[q * 128 + d6 + 64];
      tot0 += a; tot1 += bq;
      bool inc = dir == 0 ? (q < tq) : (q > tq);
      if (inc) { off0 += a; off1 += bq; }
    }
    const float dec0 = __expf(tot0), dec1 = __expf(tot1);
    if (tq == 0) { DEC[(size_t)it * 128 + d6] = dec0; DEC[(size_t)it * 128 + d6 + 64] = dec1; }
    const bool do_rope = n >= 4;
    unsigned ke0[8], ke1[8];
    float run0 = 0.f, run1 = 0.f, keprev0 = 0.f, keprev1 = 0.f;
#pragma unroll
    for (int hb = 0; hb < 2; ++hb) {
      unsigned qv[8], kv[8]; float csv[8], snv[8];
#pragma unroll
      for (int t8 = 0; t8 < 8; ++t8) {
        const int tt = hb * 8 + t8, t = tq * 16 + tt;
        const int o0 = t * 256 + (((d6 >> 3) ^ tt) << 4) + (d6 & 7) * 2;
        const int o1 = t * 256 + ((((d6 >> 3) + 8) ^ tt) << 4) + (d6 & 7) * 2;
        qv[t8] = (unsigned)*(const u16*)(qS + o0) | ((unsigned)*(const u16*)(qS + o1) << 16);
        kv[t8] = (unsigned)*(const u16*)(kS + o0) | ((unsigned)*(const u16*)(kS + o1) << 16);
        const int pos = d6 < 32 ? (do_rope ? n - 4 : 0) : t;
        csv[t8] = ropeL[pos * 32 + (d6 & 31)]; snv[t8] = ropeL[2048 + pos * 32 + (d6 & 31)];
      }
      asm volatile("" ::: "memory");
#pragma unroll
      for (int t8 = 0; t8 < 8; ++t8) {
        const int tt = hb * 8 + t8, t = tq * 16 + tt;
        const float rp0 = run0, rp1 = run1;
        run0 += la0[tt]; run1 += la1[tt];
        const float c0 = dir == 0 ? off0 + run0 : off0 + (s0 - rp0), c1 = dir == 0 ? off1 + run1 : off1 + (s1 - rp1);
        const float qb0 = dir == 0 ? c0 : c0 - la0[tt], qb1 = dir == 0 ? c1 : c1 - la1[tt];
        const int o0 = t * 256 + (((d6 >> 3) ^ tt) << 4) + (d6 & 7) * 2;
        const int o1 = t * 256 + ((((d6 >> 3) + 8) ^ tt) << 4) + (d6 & 7) * 2;
        float q0 = bf_lo(qv[t8]), q1 = bf_hi(qv[t8]);
        float k0 = bf_lo(kv[t8]), k1 = bf_hi(kv[t8]);
        if (do_rope) {
          const float cs = csv[t8], sn = snv[t8];
          float a = q0 * cs - q1 * sn, bq = q0 * sn + q1 * cs; q0 = a; q1 = bq;
          a = k0 * cs - k1 * sn; bq = k0 * sn + k1 * cs; k0 = a; k1 = bq;
        }
        const float kt0 = k0 * __expf(-c0), kt1 = k1 * __expf(-c1);
        *(u16*)(qS + o0) = f2bf(q0 * __expf(qb0)); *(u16*)(qS + o1) = f2bf(q1 * __expf(qb1));
        *(u16*)(kS + o0) = f2bf(kt0); *(u16*)(kS + o1) = f2bf(kt1);
        const float e0 = kt0 * dec0, e1 = kt1 * dec1;
        if (tt & 1) { ke0[tt >> 1] = pk2(keprev0, e0); ke1[tt >> 1] = pk2(keprev1, e1); } else { keprev0 = e0; keprev1 = e1; }
      }
      asm volatile("" ::: "memory");
    }
    {
      char* kimg = smem + 57344;
      u32x4 a = {ke0[0], ke0[1], ke0[2], ke0[3]}, bq = {ke0[4], ke0[5], ke0[6], ke0[7]};
      *(u32x4*)(kimg + d6 * 128 + (((tq * 2) ^ (d6 & 7)) << 4)) = a; *(u32x4*)(kimg + d6 * 128 + (((tq * 2 + 1) ^ (d6 & 7)) << 4)) = bq;
      u32x4 c = {ke1[0], ke1[1], ke1[2], ke1[3]}, d = {ke1[4], ke1[5], ke1[6], ke1[7]};
      *(u32x4*)(kimg + (d6 + 64) * 128 + (((tq * 2) ^ (d6 & 7)) << 4)) = c; *(u32x4*)(kimg + (d6 + 64) * 128 + (((tq * 2 + 1) ^ (d6 & 7)) << 4)) = d;
    }
    __syncthreads();
#pragma unroll
    for (int i = 0; i < 4; ++i) {
      const int c = tid + 256 * i, row = c >> 3, ch = c & 7;
      u32x4 v = *(const u32x4*)(smem + 57344 + row * 128 + ((ch ^ (row & 7)) << 4));
      *(u32x4*)(KE + (size_t)it * 8192 + c * 8) = v;
    }
#pragma unroll
    for (int i = 0; i < 4; ++i) {
      int c = tid + 256 * i, row = c >> 4, ch = c & 15;
      u32x4 v = *(const u32x4*)(qS + row * 256 + ((ch ^ (row & 15)) << 4));
      *(u32x4*)(QT + (size_t)it * 8192 + c * 8) = v;
    }
    {
      f32x4 at[4];
#pragma unroll
      for (int st = 0; st < 4; ++st) at[st] = (f32x4){0.f, 0.f, 0.f, 0.f};
#pragma unroll
      for (int kk = 0; kk < 4; ++kk) {
        const int co = ((kk * 4 + g) ^ l15) << 4;
        bf16x8 qf = *(const bf16x8*)(qS + (16 * w + l15) * 256 + co);
#pragma unroll
        for (int st = 0; st < 4; ++st) {
          bf16x8 kf = *(const bf16x8*)(kS + (16 * st + l15) * 256 + co);
          at[st] = mfma16(kf, qf, at[st]);
        }
      }
      const int t = 16 * w + l15;
#pragma unroll
      for (int st = 0; st < 4; ++st) {
        float v[4];
#pragma unroll
        for (int jj = 0; jj < 4; ++jj) { int s = 16 * st + 4 * g + jj; bool keep = dir == 0 ? (s <= t) : (s > t); v[jj] = keep ? at[st][jj] : 0.f; }
        u32x2 o = {pk2(v[0], v[1]), pk2(v[2], v[3])};
        *(u32x2*)(ATT + (size_t)it * 4096 + t * 64 + 16 * st + 4 * g) = o;
      }
    }
  }
}

DI void gla_chain_phase(const Ctx& cx, const Params& p, char* smem) {
  const int tid = cx.tid, lane = tid & 63, w = tid >> 6, l15 = lane & 15, g = lane >> 4;
  char* qtS = smem; char* keS = smem + 16384; char* atS = smem + 32768; char* vtS = smem + 40960; float* decS = (float*)(smem + 49152);
  const u16* QT = (const u16*)(p.ws + OFF_R2); const u16* KE = (const u16*)(p.ws + OFF_R5); const u16* ATT = (const u16*)(p.ws + OFF_R6);
  const u16* VT = (const u16*)(p.ws + OFF_R3); const float* DEC = (const float*)(p.ws + OFF_DEC);
  const int sw7 = (l15 >> 1) & 7;
  for (int it = cx.bid; it < 256; it += cx.nblk) {
    const int sl = it & 3, dir = (it >> 2) & 1, h = (it >> 3) & 3, b = it >> 5;
    u16* O = (u16*)(p.ws + (dir == 0 ? OFF_R1 : OFF_R0));
    f32x4 S[8]; bf16x8 Sbf[4];
#pragma unroll
    for (int a = 0; a < 8; ++a) S[a] = (f32x4){0.f, 0.f, 0.f, 0.f};
#pragma unroll
    for (int kk = 0; kk < 4; ++kk) Sbf[kk] = (bf16x8){0, 0, 0, 0, 0, 0, 0, 0};
    u32x4 pf[12]; f32x4 pfd = {0.f, 0.f, 0.f, 0.f};
    auto chunk_of = [&](int j) { return dir == 0 ? j : (j < 4 ? 3 - j : 39 - j); };
    auto issue = [&](int j) {
      const int n = chunk_of(j);
      const size_t pi = ((size_t)(b * NCHUNK + n) * 4 + h) * 2 + dir;
      const char* qb = (const char*)(QT + pi * 8192); const char* kb = (const char*)(KE + pi * 8192); const char* ab = (const char*)(ATT + pi * 4096);
      const char* vb = (const char*)(VT + ((size_t)b * 1024 + h * 256 + sl * 64) * LSEQ + n * 64);
      const unsigned lo = (unsigned)tid * 16u;
#pragma unroll
      for (int i = 0; i < 4; ++i) pf[i] = *(const u32x4*)(qb + lo + i * 4096);
#pragma unroll
      for (int i = 0; i < 4; ++i) pf[4 + i] = *(const u32x4*)(kb + lo + i * 4096);
#pragma unroll
      for (int i = 0; i < 2; ++i) pf[8 + i] = *(const u32x4*)(ab + lo + i * 4096);
#pragma unroll
      for (int i = 0; i < 2; ++i) { const unsigned c = tid + 256 * i, row = c >> 3, ch = c & 7; pf[10 + i] = *(const u32x4*)(vb + (row * LSEQ + ch * 8) * 2u); }
      if (tid < 32) pfd = *(const f32x4*)(DEC + pi * 128 + tid * 4);
    };
    auto commit = [&]() {
#pragma unroll
      for (int i = 0; i < 4; ++i) { int c = tid + 256 * i, row = c >> 4, ch = c & 15; *(u32x4*)(qtS + row * 256 + ((ch ^ (row & 15)) << 4)) = pf[i]; }
#pragma unroll
      for (int i = 0; i < 4; ++i) { int c = tid + 256 * i, row = c >> 3, ch = c & 7; *(u32x4*)(keS + row * 128 + ((ch ^ ((row >> 1) & 7)) << 4)) = pf[4 + i]; }
#pragma unroll
      for (int i = 0; i < 2; ++i) { int c = tid + 256 * i, row = c >> 3, ch = c & 7; *(u32x4*)(atS + row * 128 + ((ch ^ ((row >> 1) & 7)) << 4)) = pf[8 + i]; }
#pragma unroll
      for (int i = 0; i < 2; ++i) { int c = tid + 256 * i, row = c >> 3, ch = c & 7; *(u32x4*)(vtS + row * 128 + ((ch ^ ((row >> 1) & 7)) << 4)) = pf[10 + i]; }
      if (tid < 32) *(f32x4*)(decS + tid * 4) = pfd;
    };
    __syncthreads();
    issue(0); commit();
    __syncthreads();
    for (int j = 0; j < NCHUNK; ++j) {
      const int n = chunk_of(j);
      if (j + 1 < NCHUNK) issue(j + 1);
#define SB __builtin_amdgcn_sched_barrier(0)
#define LOADQ(QF, KK0) do { _Pragma("unroll") for (int k2 = 0; k2 < 2; ++k2) _Pragma("unroll") for (int tt = 0; tt < 4; ++tt) { \
        const int row = 16 * tt + l15; const int e0 = 32 * ((KK0) + k2) + 4 * g, e1 = e0 + 16; \
        u32x2 lo = *(const u32x2*)(qtS + row * 256 + (((e0 >> 3) ^ l15) << 4) + (e0 & 7) * 2); \
        u32x2 hi = *(const u32x2*)(qtS + row * 256 + (((e1 >> 3) ^ l15) << 4) + (e1 & 7) * 2); \
        u32x4 q4 = {lo[0], lo[1], hi[0], hi[1]}; QF[k2][tt] = __builtin_bit_cast(bf16x8, q4); } } while (0)
      bf16x8 vf[2], af[4][2];
#pragma unroll
      for (int kk = 0; kk < 2; ++kk) vf[kk] = *(const bf16x8*)(vtS + (16 * w + l15) * 128 + (((kk * 4 + g) ^ sw7) << 4));
#pragma unroll
      for (int tt = 0; tt < 4; ++tt)
#pragma unroll
        for (int kk = 0; kk < 2; ++kk) af[tt][kk] = *(const bf16x8*)(atS + (16 * tt + l15) * 128 + (((kk * 4 + g) ^ sw7) << 4));
      bf16x8 qa[2][4];
      LOADQ(qa, 0);
      SB;
      f32x4 o[4];
#pragma unroll
      for (int tt = 0; tt < 4; ++tt) {
        o[tt] = mfma16(vf[0], af[tt][0], (f32x4){0.f, 0.f, 0.f, 0.f});
        o[tt] = mfma16(vf[1], af[tt][1], o[tt]);
      }
      SB;
      bf16x8 qb[2][4];
      LOADQ(qb, 2);
      SB;
#pragma unroll
      for (int k2 = 0; k2 < 2; ++k2)
#pragma unroll
        for (int tt = 0; tt < 4; ++tt) o[tt] = mfma16(Sbf[k2], qa[k2][tt], o[tt]);
      SB;
#define LOADK(KF, DF, A0) do { _Pragma("unroll") for (int a = 0; a < 2; ++a) { DF[a] = *(const f32x4*)(decS + 16 * ((A0) + a) + 4 * g); \
        _Pragma("unroll") for (int kk = 0; kk < 2; ++kk) KF[a][kk] = *(const bf16x8*)(keS + (16 * ((A0) + a) + l15) * 128 + (((kk * 4 + g) ^ sw7) << 4)); } } while (0)
#define SUPD(KF, DF, A0) do { _Pragma("unroll") for (int a = 0; a < 2; ++a) { S[(A0) + a] *= DF[a]; \
        S[(A0) + a] = mfma16(KF[a][0], vf[0], S[(A0) + a]); S[(A0) + a] = mfma16(KF[a][1], vf[1], S[(A0) + a]); } } while (0)
      bf16x8 k0[2][2], k1[2][2]; f32x4 d0[2], d1[2];
      LOADK(k0, d0, 0);
      SB;
#pragma unroll
      for (int k2 = 0; k2 < 2; ++k2)
#pragma unroll
        for (int tt = 0; tt < 4; ++tt) o[tt] = mfma16(Sbf[2 + k2], qb[k2][tt], o[tt]);
      SB;
      LOADK(k1, d1, 2);
      SB;
      SUPD(k0, d0, 0);
      SB;
#pragma unroll
      for (int tt = 0; tt < 4; ++tt) {
        size_t m = (size_t)b * LSEQ + n * 64 + 16 * tt + l15;
        u32x2 ov = {pk2(o[tt][0], o[tt][1]), pk2(o[tt][2], o[tt][3])};
        *(u32x2*)(O + m * 1024 + h * 256 + sl * 64 + 16 * w + 4 * g) = ov;
      }
      LOADK(k0, d0, 4);
      SB;
      SUPD(k1, d1, 2);
      SB;
      LOADK(k1, d1, 6);
      SB;
      SUPD(k0, d0, 4);
      SB;
      SUPD(k1, d1, 6);
#undef LOADK
#undef SUPD
#undef SB
#undef LOADQ
#pragma unroll
      for (int kk = 0; kk < 4; ++kk) {
        u32x4 s4 = {pk2(S[2 * kk][0], S[2 * kk][1]), pk2(S[2 * kk][2], S[2 * kk][3]), pk2(S[2 * kk + 1][0], S[2 * kk + 1][1]), pk2(S[2 * kk + 1][2], S[2 * kk + 1][3])};
        Sbf[kk] = __builtin_bit_cast(bf16x8, s4);
      }
      __syncthreads();
      if (j + 1 < NCHUNK) { commit(); __syncthreads(); }
    }
  }
}

DI void gla_merge_phase(const Ctx& cx, const Params& p, int layer) {
  const int lane = cx.tid & 63, wg = (cx.bid * 256 + cx.tid) >> 6, nw = cx.nblk * 4;
  const u16* OF = (const u16*)(p.ws + OFF_R1); u16* OB = (u16*)(p.ws + OFF_R0); const u16* G = (const u16*)(p.ws + OFF_R4);
  const float* ng = p.gla_norm_g + (layer >> 1) * 256 + (lane & 15) * 16;
  float ngv[16];
#pragma unroll
  for (int i = 0; i < 16; ++i) ngv[i] = ng[i];
  for (int m0 = wg; m0 < MROWS; m0 += 2 * nw) {
    float o[2][16], gv[2][16];
#pragma unroll
    for (int q = 0; q < 2; ++q) {
      const int m = m0 + q * nw;
      if (m < MROWS) {
        const size_t base = (size_t)m * 1024 + lane * 16;
#pragma unroll
        for (int hlf = 0; hlf < 2; ++hlf) {
          u32x4 a = *(const u32x4*)(OF + base + hlf * 8), bq = *(const u32x4*)(OB + base + hlf * 8), c = *(const u32x4*)(G + base + hlf * 8);
#pragma unroll
          for (int e = 0; e < 4; ++e) {
            o[q][hlf * 8 + 2 * e] = bf_lo(a[e]) + bf_lo(bq[e]); o[q][hlf * 8 + 2 * e + 1] = bf_hi(a[e]) + bf_hi(bq[e]);
            gv[q][hlf * 8 + 2 * e] = bf_lo(c[e]); gv[q][hlf * 8 + 2 * e + 1] = bf_hi(c[e]);
          }
        }
      }
    }
#pragma unroll
    for (int q = 0; q < 2; ++q) {
      const int m = m0 + q * nw;
      if (m >= MROWS) continue;
      const size_t base = (size_t)m * 1024 + lane * 16;
      float ss = 0.f;
#pragma unroll
      for (int i = 0; i < 16; ++i) ss += o[q][i] * o[q][i];
      ss += __shfl_xor(ss, 1); ss += __shfl_xor(ss, 2); ss += __shfl_xor(ss, 4); ss += __shfl_xor(ss, 8);
      const float r = rsqrtf(ss * (1.f / 256.f) + 1e-6f);
      unsigned ov[8];
#pragma unroll
      for (int e = 0; e < 8; ++e) {
        float v0 = o[q][2 * e] * r * ngv[2 * e] * siluf(gv[q][2 * e]), v1 = o[q][2 * e + 1] * r * ngv[2 * e + 1] * siluf(gv[q][2 * e + 1]);
        ov[e] = pk2(v0, v1);
      }
      u32x4 w0 = {ov[0], ov[1], ov[2], ov[3]}, w1 = {ov[4], ov[5], ov[6], ov[7]};
      *(u32x4*)(OB + base) = w0; *(u32x4*)(OB + base + 8) = w1;
    }
  }
}

DI void ln_phase(const Ctx& cx, const Params& p, int layer, char* smem) {
  const int lane = cx.tid & 63, wg = (cx.bid * 256 + cx.tid) >> 6, nw = cx.nblk * 4;
  const float* mod = (const float*)(p.ws + OFF_MOD);
  const u16* Y = (const u16*)(p.ws + OFF_R2);
  u16* H = (u16*)(p.ws + OFF_R0);
  const bool last = layer == 3;
  f32x4 gg[4], bb[4];
#pragma unroll
  for (int i = 0; i < 4; ++i) { const int c = 4 * lane + 256 * i; gg[i] = *(const f32x4*)(p.ln_g + layer * 1024 + c); bb[i] = *(const f32x4*)(p.ln_b + layer * 1024 + c); }
  for (int m0 = wg; m0 < MROWS; m0 += 2 * nw) {
    float v[2][16]; f32x4 shn[2][4], scn[2][4];
    float sum[2] = {0.f, 0.f};
    bool act[2];
#pragma unroll
    for (int q = 0; q < 2; ++q) {
      const int m = m0 + q * nw;
      const int b = m / LSEQ, pos = m % LSEQ;
      act[q] = (m < MROWS) && !(last && pos < CTXL);
      if (act[q]) {
        const int cond = pos < CTXL ? 8 : b;
        const float* xr = resid_in(p, layer, b, pos);
        const float* md = mod + (size_t)(layer * 9 + cond) * 3072;
        const float* mdn = mod + (size_t)((layer + 1) * 9 + cond) * 3072;
#pragma unroll
        for (int i = 0; i < 4; ++i) {
          const int c = 4 * lane + 256 * i;
          f32x4 xv = *(const f32x4*)(xr + c), gt = *(const f32x4*)(md + 2048 + c);
          u32x2 yv = *(const u32x2*)(Y + (size_t)m * 1024 + c);
          if (!last) { shn[q][i] = *(const f32x4*)(mdn + c); scn[q][i] = *(const f32x4*)(mdn + 1024 + c); }
          v[q][4 * i + 0] = ALPHA * xv[0] + gt[0] * bf_lo(yv[0]); v[q][4 * i + 1] = ALPHA * xv[1] + gt[1] * bf_hi(yv[0]);
          v[q][4 * i + 2] = ALPHA * xv[2] + gt[2] * bf_lo(yv[1]); v[q][4 * i + 3] = ALPHA * xv[3] + gt[3] * bf_hi(yv[1]);
          sum[q] += v[q][4 * i] + v[q][4 * i + 1] + v[q][4 * i + 2] + v[q][4 * i + 3];
        }
      }
    }
#pragma unroll
    for (int q = 0; q < 2; ++q) {
      if (!act[q]) continue;
      const int m = m0 + q * nw;
      const int b = m / LSEQ, pos = m % LSEQ;
      float* xo = resid_out(p, b, pos);
      float sm = sum[q];
#pragma unroll
      for (int s2 = 1; s2 < 64; s2 <<= 1) sm += __shfl_xor(sm, s2);
      const float mu = sm * (1.f / 1024.f);
      float var = 0.f;
#pragma unroll
      for (int i = 0; i < 16; ++i) { float d = v[q][i] - mu; var += d * d; }
#pragma unroll
      for (int s2 = 1; s2 < 64; s2 <<= 1) var += __shfl_xor(var, s2);
      const float rstd = rsqrtf(var * (1.f / 1024.f) + 1e-5f);
#pragma unroll
      for (int i = 0; i < 4; ++i) {
        const int c = 4 * lane + 256 * i;
        f32x4 xn;
#pragma unroll
        for (int e = 0; e < 4; ++e) xn[e] = (v[q][4 * i + e] - mu) * rstd * gg[i][e] + bb[i][e];
        *(f32x4*)(xo + c) = xn;
        if (!last) {
          f32x4 hh = xn * (scn[q][i] + 1.f) + shn[q][i];
          u32x2 o = {pk2(hh[0], hh[1]), pk2(hh[2], hh[3])};
          *(u32x2*)(H + (size_t)m * 1024 + c) = o;
        }
      }
    }
  }
  if (!last) {
    const int nconv = convert_items(layer + 1);
    for (int it = cx.bid; it < nconv; it += cx.nblk) convert_item(cx, p, layer + 1, it, smem);
  }
}

DI void na_attn_phase(const Ctx& cx, const Params& p, int layer, char* smem) {
  const int tid = cx.tid, lane = tid & 63, w = tid >> 6, l15 = lane & 15, g = lane >> 4;
  const bool need_ctx = layer < 3;
  const int RPI = need_ctx ? 18 : 16;
  const u16* Q = (const u16*)(p.ws + OFF_R1); const u16* K = (const u16*)(p.ws + OFF_R2); const u16* VT = (const u16*)(p.ws + OFF_R3);
  const u16* G = (const u16*)(p.ws + OFF_R4); u16* MG = (u16*)(p.ws + OFF_R0);
  float* rpbS = (float*)(smem + 65536 + 64);
  const char* Qs = smem + 32768;
  const int sw7 = (l15 >> 1) & 7;
  const int nitems = NB * 16 * RPI;
  const int ws = w == 0 ? 0 : (w == 1 ? 8 : (w == 2 ? 24 : 32));
  const int qc = 16 * w + l15;
  const int cs = min(max(qc - 8, 0), 48);
  const int d0 = ws + 4 * g - cs;
  const int bi0 = ws + 4 * g - qc + 15;
  const int kls = ((ws + l15) >> 1) & 7;
  const int kL0 = (ws + l15) * 128 + ((g ^ kls) << 4), kL1 = (ws + l15) * 128 + (((4 + g) ^ kls) << 4);
  const int kC0 = l15 * 128 + ((g ^ sw7) << 4), kC1 = l15 * 128 + (((4 + g) ^ sw7) << 4);
  const int vL0 = l15 * 128 + ((((ws >> 3) + (g >> 1)) ^ sw7) << 4) + (g & 1) * 8, vL1 = l15 * 128 + ((((ws >> 3) + 2 + (g >> 1)) ^ sw7) << 4) + (g & 1) * 8;
  const int vC0 = l15 * 128 + (((g >> 1) ^ sw7) << 4) + (g & 1) * 8, vC1 = l15 * 128 + (((2 + (g >> 1)) ^ sw7) << 4) + (g & 1) * 8;
  const int vC2 = l15 * 128 + (((4 + (g >> 1)) ^ sw7) << 4) + (g & 1) * 8, vC3 = l15 * 128 + (((6 + (g >> 1)) ^ sw7) << 4) + (g & 1) * 8;
  for (int it = cx.bid; it < nitems; it += cx.nblk) {
    const int rg = it % RPI, bh = it / RPI, h = bh & 15, b = bh >> 4;
    const bool lat = rg < 16;
    const int r0 = rg * 2;
    const int ylo = lat ? min(max(r0 - 4, 0), 24) : 0;
    const int yhi = lat ? min(max(r0 + 1 - 4, 0), 24) + 7 : -1;
    const int nloc = yhi - ylo + 1;
    const int nst = nloc + 4;
    const int mbase = b * LSEQ + (lat ? CTXL + r0 * 64 : (rg - 16) * 128);
    __syncthreads();
    for (int i = tid; i < 465; i += 256) rpbS[i] = p.na_rpb[((size_t)(layer >> 1) * 16 + h) * 465 + i] * 1.4426950408889634f;
#pragma unroll
    for (int i = 0; i < 4; ++i) {
      const int c = tid + 256 * i, qrow = c >> 3, ch = c & 7;
      u32x4 v = *(const u32x4*)(Q + (unsigned)((mbase + qrow) * 1024 + h * 64 + ch * 8));
      *(u32x4*)(smem + 32768 + qrow * 128 + ((ch ^ ((qrow >> 1) & 7)) << 4)) = v;
    }
    auto issue = [&](int st, int buf) {
      const int p0 = st < nloc ? CTXL + (ylo + st) * 64 : (st - nloc) * 64;
#pragma unroll
      for (int i = 0; i < 2; ++i) {
        const int row = w * 16 + i * 8 + (lane >> 3), ch = (lane & 7) ^ ((row >> 1) & 7);
        __builtin_amdgcn_global_load_lds((const unsigned*)(K + (unsigned)((b * LSEQ + p0 + row) * 1024 + h * 64 + ch * 8)), (unsigned*)(smem + buf * 16384 + w * 2048 + i * 1024 + lane * 16), 16, 0, 0);
        const int r32 = row & 31, vrow = (row & ~31) + 8 * ((r32 & 15) >> 2) + 4 * (r32 >> 4) + (r32 & 3);
        __builtin_amdgcn_global_load_lds((const unsigned*)(VT + (unsigned)((b * 1024 + h * 64 + vrow) * LSEQ + p0 + ch * 8)), (unsigned*)(smem + buf * 16384 + 8192 + w * 2048 + i * 1024 + lane * 16), 16, 0, 0);
      }
    };
    issue(0, 0);
    __syncthreads();
    float mrun[2], lrun[2];
    f32x4 o[2][4];
#pragma unroll
    for (int rr = 0; rr < 2; ++rr) {
      mrun[rr] = -1e20f; lrun[rr] = 0.f;
#pragma unroll
      for (int dt = 0; dt < 4; ++dt) o[rr][dt] = (f32x4){0.f, 0.f, 0.f, 0.f};
    }
    auto block = [&](const char* Ks, const char* Vs, int k0off, int k1off, int v0off, int v1off, bool local, int y, int ist, int ibuf) {
#pragma unroll
      for (int pr = 0; pr < 1; ++pr) {
        bf16x8 kf[2][2];
#pragma unroll
        for (int kt = 0; kt < 2; ++kt) { kf[kt][0] = *(const bf16x8*)(Ks + k0off + kt * 2048); kf[kt][1] = *(const bf16x8*)(Ks + k1off + kt * 2048); }
        if (ist >= 0) issue(ist, ibuf);
        f32x4 sc[2][2];
#pragma unroll
        for (int q2 = 0; q2 < 2; ++q2) {
          const int rr = 2 * pr + q2;
          const bf16x8 qf0 = *(const bf16x8*)(Qs + rr * 8192 + w * 2048 + kC0), qf1 = *(const bf16x8*)(Qs + rr * 8192 + w * 2048 + kC1);
          const int r = r0 + rr;
          const int rs = min(max(r - 4, 0), 24);
          const bool active = (y >= rs) && (y < rs + 8);
          float bv[8];
          if (local) {
            const float* bp = rpbS + ((y - r + 7) * 31 + bi0);
#pragma unroll
            for (int kt = 0; kt < 2; ++kt)
#pragma unroll
              for (int jj = 0; jj < 4; ++jj) bv[kt * 4 + jj] = bp[16 * kt + jj];
            asm volatile("" : "+v"(bv[0]), "+v"(bv[1]), "+v"(bv[2]), "+v"(bv[3]), "+v"(bv[4]), "+v"(bv[5]), "+v"(bv[6]), "+v"(bv[7]));
          }
#pragma unroll
          for (int kt = 0; kt < 2; ++kt) {
            sc[q2][kt] = mfma16(kf[kt][0], qf0, (f32x4){0.f, 0.f, 0.f, 0.f});
            sc[q2][kt] = mfma16(kf[kt][1], qf1, sc[q2][kt]);
          }
          if (local) {
#pragma unroll
            for (int kt = 0; kt < 2; ++kt)
#pragma unroll
              for (int jj = 0; jj < 4; ++jj) {
                const bool valid = active && ((unsigned)(d0 + 16 * kt + jj) < 16u);
                sc[q2][kt][jj] = valid ? sc[q2][kt][jj] + bv[kt * 4 + jj] : -1e30f;
              }
          }
        }
        float mx[2];
        bool need = false;
#pragma unroll
        for (int q2 = 0; q2 < 2; ++q2) {
          float m = fmaxf(fmaxf(fmaxf(sc[q2][0][0], sc[q2][0][1]), fmaxf(sc[q2][0][2], sc[q2][0][3])), fmaxf(fmaxf(sc[q2][1][0], sc[q2][1][1]), fmaxf(sc[q2][1][2], sc[q2][1][3])));
          mx[q2] = m; need = need || (m > mrun[2 * pr + q2] + 8.f);
        }
        if (__builtin_amdgcn_ballot_w64(need) != 0ull) {
#pragma unroll
          for (int q2 = 0; q2 < 2; ++q2) {
            const int rr = 2 * pr + q2;
            float m = mx[q2];
            m = fmaxf(m, __shfl_xor(m, 16)); m = fmaxf(m, __shfl_xor(m, 32));
            const float mnew = fmaxf(mrun[rr], m);
            const float alpha = __builtin_amdgcn_exp2f(mrun[rr] - mnew);
            mrun[rr] = mnew; lrun[rr] *= alpha;
#pragma unroll
            for (int dt = 0; dt < 4; ++dt) o[rr][dt] *= alpha;
          }
        }
        bf16x8 pfrag[2];
#pragma unroll
        for (int q2 = 0; q2 < 2; ++q2) {
          const int rr = 2 * pr + q2;
          const float mcur = mrun[rr];
          float ps = 0.f;
#pragma unroll
          for (int kt = 0; kt < 2; ++kt)
#pragma unroll
            for (int jj = 0; jj < 4; ++jj) { float e = __builtin_amdgcn_exp2f(sc[q2][kt][jj] - mcur); sc[q2][kt][jj] = e; ps += e; }
          lrun[rr] += ps;
          u32x4 p4 = {pk2(sc[q2][0][0], sc[q2][0][1]), pk2(sc[q2][0][2], sc[q2][0][3]), pk2(sc[q2][1][0], sc[q2][1][1]), pk2(sc[q2][1][2], sc[q2][1][3])};
          pfrag[q2] = __builtin_bit_cast(bf16x8, p4);
        }
#pragma unroll
        for (int dt = 0; dt < 4; ++dt) {
          u32x2 lo = *(const u32x2*)(Vs + v0off + dt * 2048);
          u32x2 hi = *(const u32x2*)(Vs + v1off + dt * 2048);
          u32x4 v4 = {lo[0], lo[1], hi[0], hi[1]};
          const bf16x8 vf = __builtin_bit_cast(bf16x8, v4);
#pragma unroll
          for (int q2 = 0; q2 < 2; ++q2) o[2 * pr + q2][dt] = mfma16(vf, pfrag[q2], o[2 * pr + q2][dt]);
        }
        __builtin_amdgcn_sched_barrier(0);
      }
    };
    for (int st = 0; st < nst; ++st) {
      const int buf = st & 1;
      const char* Ks = smem + buf * 16384; const char* Vs = Ks + 8192;
      const int ist = st + 1 < nst ? st + 1 : -1;
      if (st < nloc) {
        block(Ks, Vs, kL0, kL1, vL0, vL1, true, ylo + st, ist, buf ^ 1);
      } else {
        block(Ks, Vs, kC0, kC1, vC0, vC1, false, 0, ist, buf ^ 1);
        __builtin_amdgcn_sched_barrier(0);
        block(Ks, Vs, kC0 + 4096, kC1 + 4096, vC2, vC3, false, 0, -1, 0);
      }
      __syncthreads();
    }
#pragma unroll
    for (int rr = 0; rr < 2; ++rr) {
      float l = lrun[rr];
      l += __shfl_xor(l, 16); l += __shfl_xor(l, 32);
      const float inv = __builtin_amdgcn_rcpf(l);
#pragma unroll
      for (int dp = 0; dp < 2; ++dp) {
        const unsigned a = (unsigned)((mbase + rr * 64 + 16 * w + l15) * 1024 + h * 64 + dp * 32 + 8 * g);
        u32x4 gv = *(const u32x4*)(G + a);
        const f32x4 oa = o[rr][2 * dp] * inv, ob = o[rr][2 * dp + 1] * inv;
        u32x4 ov = {pk2(oa[0] * siluf(bf_lo(gv[0])), oa[1] * siluf(bf_hi(gv[0]))), pk2(oa[2] * siluf(bf_lo(gv[1])), oa[3] * siluf(bf_hi(gv[1]))),
                    pk2(ob[0] * siluf(bf_lo(gv[2])), ob[1] * siluf(bf_hi(gv[2]))), pk2(ob[2] * siluf(bf_lo(gv[3])), ob[3] * siluf(bf_hi(gv[3])))};
        *(u32x4*)(MG + a) = ov;
      }
    }
  }
}

#define XB_TMO      128
#define XB_XCNT(j)  (256  + 64 * (j))
#define XB_XSUB(j)  (1280 + 64 * (j))
#define XB_XGEN(j)  (2304 + 64 * (j))
#define XB_TOP      3328
#define XB_TOPGEN   3392
#define XCD_BAR_WORDS 3456
#define XB_SPIN_CAP (1u << 22)
#define LAS __attribute__((address_space(3)))
DI unsigned xb_ld(unsigned* p)              { return __hip_atomic_load(p, __ATOMIC_RELAXED, __HIP_MEMORY_SCOPE_AGENT); }
DI unsigned xb_add(unsigned* p, unsigned v) { return __hip_atomic_fetch_add(p, v, __ATOMIC_RELAXED, __HIP_MEMORY_SCOPE_AGENT); }
DI unsigned xb_xcc_id() { return (unsigned)__builtin_amdgcn_s_getreg((3 << 11) | 20) & 0xFu; }
#define XB_SPIN(cond, bar) do { unsigned _sp = 0; while (cond) { __builtin_amdgcn_s_sleep(1); \
    if ((++_sp & 255u) == 0u) { if (xb_ld(&(bar)[XB_TMO])) break; if (_sp > XB_SPIN_CAP) { atomicAdd(&(bar)[XB_TMO], 1u); break; } } } } while (0)
struct XcdBarrier { unsigned* bar; unsigned x; volatile LAS unsigned* st; };
DI XcdBarrier xcd_barrier_post(unsigned* bar, volatile LAS unsigned* st) {
  XcdBarrier b; b.bar = bar; b.x = xb_xcc_id(); b.st = st;
  if (threadIdx.x == 0) (void)xb_add(&bar[XB_XCNT(b.x)], 1u);
  return b;
}
DI void xcd_barrier_complete(unsigned* bar, unsigned x, unsigned& nloc, unsigned& nx) {
  const unsigned G = gridDim.x * gridDim.y * gridDim.z;
  unsigned sum, cnt, mine, sp = 0u;
  for (;;) {
    sum = 0u; cnt = 0u; mine = 0u;
#pragma unroll
    for (unsigned j = 0; j < 16; ++j) { const unsigned c = xb_ld(&bar[XB_XCNT(j)]); sum += c; cnt += (c > 0u) ? 1u : 0u; mine = (j == x) ? c : mine; }
    if (sum == G) break;
    __builtin_amdgcn_s_sleep(1);
    if ((++sp & 255u) == 0u) { if (xb_ld(&bar[XB_TMO])) break; if (sp > XB_SPIN_CAP) { atomicAdd(&bar[XB_TMO], 1u); break; } }
  }
  nloc = mine > 0u ? mine : 1u; nx = cnt > 0u ? cnt : 1u;
}
DI void xcd_barrier(const XcdBarrier& b) {
  asm volatile("s_waitcnt vmcnt(0)" ::: "memory");
  __syncthreads();
  if (threadIdx.x == 0) {
    unsigned* bar = b.bar;
    __builtin_amdgcn_s_waitcnt(0);
    unsigned nloc = b.st[0], nx = b.st[1];
    if (nloc == 0u) { xcd_barrier_complete(bar, b.x, nloc, nx); b.st[0] = nloc; b.st[1] = nx; }
    const unsigned old = xb_add(&bar[XB_XSUB(b.x)], 1u);
    const unsigned gen = old / nloc;
    if (old + 1u == (gen + 1u) * nloc) {
      __builtin_amdgcn_fence(__ATOMIC_RELEASE, "agent");
      asm volatile("s_waitcnt vmcnt(0)" ::: "memory");
      const unsigned og = xb_add(&bar[XB_TOP], 1u);
      const unsigned tg = og / nx;
      if (og + 1u == (tg + 1u) * nx) xb_add(&bar[XB_TOPGEN], 1u);
      else XB_SPIN(xb_ld(&bar[XB_TOPGEN]) == tg, bar);
      __builtin_amdgcn_fence(__ATOMIC_ACQUIRE, "agent");
      xb_add(&bar[XB_XGEN(b.x)], 1u);
      asm volatile("s_waitcnt vmcnt(0)" ::: "memory");
    } else {
      XB_SPIN(xb_ld(&bar[XB_XGEN(b.x)]) == gen, bar);
      __builtin_amdgcn_fence(__ATOMIC_ACQUIRE, "agent");
      asm volatile("s_waitcnt vmcnt(0)" ::: "memory");
    }
  }
  __syncthreads();
}

constexpr int NPHASES = 22;
constexpr int SMEM_BYTES = 79872;
__global__ void __launch_bounds__(256, 2) fwd_megakernel(Params p) {
  __shared__ __attribute__((aligned(16))) char smem[SMEM_BYTES];
  cg::grid_group grid = cg::this_grid();
  __shared__ uint4 xb_words;
  if (threadIdx.x == 0) xb_words = make_uint4(0u, 0u, 0u, 0u);
  __syncthreads();
  XcdBarrier xb = xcd_barrier_post((unsigned*)(p.ws + OFF_BAR), (volatile LAS unsigned*)&xb_words);
  const int wave_id = __builtin_amdgcn_readfirstlane((int)(threadIdx.x >> 6));
  for (int ph = p.ph_lo; ph < p.ph_hi; ++ph) {
    Ctx cx; cx.tid = wave_id * 64 + (int)__builtin_amdgcn_mbcnt_hi(~0u, __builtin_amdgcn_mbcnt_lo(~0u, 0u)); cx.bid = blockIdx.x; cx.nblk = gridDim.x;
    asm volatile("" : "+v"(cx.tid)); asm volatile("" : "+s"(cx.bid)); asm volatile("" : "+s"(cx.nblk));
    Params pp = p;
    asm volatile("" : "+s"(pp.ws)); asm volatile("" : "+s"(pp.out));
    if (ph == 0) phase0a(cx, pp, smem);
    else if (ph == 1) phase0b(cx, pp);
    else {
      const int q = ph - 2, pair = q / 10, r = q % 10;
      const int layer = 2 * pair + (r >= 6 ? 1 : 0);
      int gk = -1;
      if (r == 0) gk = 0; else if (r == 6) gk = 1; else if (r == 4 || r == 8) gk = 2;
      asm volatile("" : "+s"(gk));
      if (gk >= 0) { for (int rep = 0; rep < (gk == 2 ? REP_GOUT : REP_GIN); ++rep) gemm_phase(cx, pp, gk, layer, smem); }
      else if (r == 5 || r == 9) ln_phase(cx, pp, layer, smem);
      else if (r == 1) { for (int rep = 0; rep < REP_PREP; ++rep) gla_prep_phase(cx, pp, layer, smem); }
      else if (r == 2) { for (int rep = 0; rep < REP_CHAIN; ++rep) gla_chain_phase(cx, pp, smem); }
      else if (r == 3) gla_merge_phase(cx, pp, layer);
      else { for (int rep = 0; rep < REP_NA; ++rep) na_attn_phase(cx, pp, layer, smem); }
    }
    if (ph + 1 < p.ph_hi) { if (p.ph_hi > NPHASES) grid.sync(); else xcd_barrier(xb); }
  }
}

extern "C" void kernel_launch(void* const* d_in, const int* in_sizes, int n_in, void* d_out, int out_size, void* d_ws, size_t ws_size, hipStream_t stream) {
  static int grid_blocks = 0;
  if (!grid_blocks) {
    int dev = 0, cus = 0, per_cu = 0;
    hipGetDevice(&dev);
    hipDeviceGetAttribute(&cus, hipDeviceAttributeMultiprocessorCount, dev);
    hipOccupancyMaxActiveBlocksPerMultiprocessor(&per_cu, fwd_megakernel, 256, 0);
    if (per_cu > 2) per_cu = 2;
    grid_blocks = cus * per_cu;
    if (grid_blocks <= 0 || (grid_blocks & 7)) grid_blocks = -1;
  }
  if (grid_blocks < 0 || ws_size < WS_END || n_in < 16) return;
  Params p{};
  p.x = (const float*)d_in[0]; p.c = (const float*)d_in[1]; p.ctx = (const float*)d_in[2]; p.c_ctx = (const float*)d_in[3];
  p.ada_w = (const float*)d_in[4]; p.ada_b = (const float*)d_in[5]; p.ln_g = (const float*)d_in[6]; p.ln_b = (const float*)d_in[7];
  p.w_out = (const float*)d_in[8]; p.gla_w_in = (const float*)d_in[9]; p.gla_dec_w1 = (const float*)d_in[10]; p.gla_dec_w2 = (const float*)d_in[11];
  p.gla_dec_b = (const float*)d_in[12]; p.gla_norm_g = (const float*)d_in[13]; p.na_w_in = (const float*)d_in[14]; p.na_rpb = (const float*)d_in[15];
  p.out = (float*)d_out; p.ws = (unsigned char*)d_ws;
#if MULTI_LAUNCH
  for (int ph = 0; ph < NPHASES; ++ph) {
    p.ph_lo = ph; p.ph_hi = ph + 1;
    hipLaunchKernelGGL(fwd_megakernel, dim3(grid_blocks), dim3(256), 0, stream, p);
  }
#else
  p.ph_lo = 0; p.ph_hi = NPHASES;
  hipMemsetAsync((char*)d_ws + OFF_BAR, 0, 3456 * 4, stream);
  void* args[] = {&p};
  hipLaunchCooperativeKernel((void*)fwd_megakernel, dim3(grid_blocks), dim3(256), args, 0, stream);
#endif
}
```

```cpp
#include <hip/hip_runtime.h>
#include <hip/hip_cooperative_groups.h>
namespace cg = cooperative_groups;

#define REP_GIN 1
#define REP_GOUT 1
#define REP_PREP 1
#define REP_CHAIN 1
#define REP_NA 1
#ifndef MULTI_LAUNCH
#define MULTI_LAUNCH 0
#endif

#define DI __device__ __forceinline__
typedef short bf16x8 __attribute__((ext_vector_type(8)));
typedef float f32x4 __attribute__((ext_vector_type(4)));
typedef float f32x2 __attribute__((ext_vector_type(2)));
typedef unsigned u32x4 __attribute__((ext_vector_type(4)));
typedef unsigned u32x2 __attribute__((ext_vector_type(2)));
typedef __bf16 bf2 __attribute__((ext_vector_type(2)));
typedef unsigned short u16;

DI unsigned pk2(float lo, float hi) { f32x2 v = {lo, hi}; bf2 b = __builtin_convertvector(v, bf2); return __builtin_bit_cast(unsigned, b); }
DI float bf_lo(unsigned u) { return __uint_as_float(u << 16); }
DI float bf_hi(unsigned u) { return __uint_as_float(u & 0xffff0000u); }
DI float bf2f(u16 h) { return __uint_as_float(((unsigned)h) << 16); }
DI u16 f2bf(float f) { return (u16)(pk2(f, 0.f) & 0xffffu); }
DI f32x4 mfma16(bf16x8 a, bf16x8 b, f32x4 c) { return __builtin_amdgcn_mfma_f32_16x16x32_bf16(a, b, c, 0, 0, 0); }
DI float siluf(float x) { return x * __builtin_amdgcn_rcpf(1.f + __expf(-x)); }

constexpr int D = 1024, NB = 8, SEQ = 2048, CTXL = 256, LSEQ = 2304, MROWS = NB * LSEQ;
constexpr int NCHUNK = 36;
constexpr size_t MiB = 1u << 20;
constexpr size_t U = 36 * MiB;
constexpr size_t OFF_R0 = 0, OFF_R1 = U, OFF_R2 = 2 * U, OFF_R3 = 3 * U, OFF_R4 = 4 * U, OFF_R5 = 5 * U, OFF_R6 = 6 * U;
constexpr size_t OFF_XCTX = 234 * MiB, OFF_WIN = 242 * MiB, OFF_WOUT = 250 * MiB, OFF_LOW = 252 * MiB;
constexpr size_t OFF_DEC = OFF_LOW + (size_t)MROWS * 32 * 2;
constexpr size_t OFF_MOD = OFF_DEC + (size_t)2304 * 128 * 4;
constexpr size_t OFF_ROPE = OFF_MOD + (size_t)4 * 9 * 3072 * 4;
constexpr size_t OFF_BAR = OFF_ROPE + (size_t)2 * 64 * 32 * 4;
constexpr size_t WS_END = OFF_BAR + 3456 * 4;
constexpr float ALPHA = 1.681792830507429f;

struct Ctx { int tid, bid, nblk; };
struct Params {
  const float *x, *c, *ctx, *c_ctx, *ada_w, *ada_b, *ln_g, *ln_b, *w_out, *gla_w_in, *gla_dec_w1, *gla_dec_w2, *gla_dec_b, *gla_norm_g, *na_w_in, *na_rpb;
  float* out; unsigned char* ws; int ph_lo, ph_hi;
};

DI void transpose_tile(const Ctx& cx, const float* __restrict__ src, int N, u16* __restrict__ dst, int k0, int n0, char* smem) {
  float* t = (float*)smem;
  const int tid = cx.tid;
  __syncthreads();
#pragma unroll
  for (int i = 0; i < 4; ++i) {
    int k = (tid >> 4) + 16 * i, n4 = (tid & 15) * 4;
    f32x4 v = *(const f32x4*)(src + (size_t)(k0 + k) * N + n0 + n4);
    t[k * 65 + n4] = v[0]; t[k * 65 + n4 + 1] = v[1]; t[k * 65 + n4 + 2] = v[2]; t[k * 65 + n4 + 3] = v[3];
  }
  __syncthreads();
#pragma unroll
  for (int j = 0; j < 2; ++j) {
    int c = tid + 256 * j, n = c >> 3, kc = (c & 7) * 8;
    u32x4 o;
    o[0] = pk2(t[(kc + 0) * 65 + n], t[(kc + 1) * 65 + n]); o[1] = pk2(t[(kc + 2) * 65 + n], t[(kc + 3) * 65 + n]);
    o[2] = pk2(t[(kc + 4) * 65 + n], t[(kc + 5) * 65 + n]); o[3] = pk2(t[(kc + 6) * 65 + n], t[(kc + 7) * 65 + n]);
    *(u32x4*)(dst + (size_t)(n0 + n) * 1024 + k0 + kc) = o;
  }
}

DI int convert_items(int layer) { return (layer & 1) ? (16 * 64 + 256) : (16 * 48 + 16 + 256); }
DI void convert_item(const Ctx& cx, const Params& p, int layer, int it, char* smem) {
  u16* win = (u16*)(p.ws + OFF_WIN); u16* wout = (u16*)(p.ws + OFF_WOUT);
  const int j = layer >> 1;
  if (layer & 1) {
    if (it < 1024) { transpose_tile(cx, p.na_w_in + (size_t)j * 1024 * 4096, 4096, win, (it >> 6) * 64, (it & 63) * 64, smem); return; }
    it -= 1024;
  } else {
    if (it < 768) { transpose_tile(cx, p.gla_w_in + (size_t)j * 1024 * 3072, 3072, win, (it / 48) * 64, (it % 48) * 64, smem); return; }
    it -= 768;
    if (it < 16) {
      const float* w1 = p.gla_dec_w1 + (size_t)j * 2 * 1024 * 16;
#pragma unroll 4
      for (int idx = cx.tid; idx < 8 * 1024; idx += 256) {
        int row = it * 8 + (idx >> 10), k = idx & 1023;
        float v = row < 32 ? w1[((size_t)(row >> 4) * 1024 + k) * 16 + (row & 15)] : 0.f;
        win[(size_t)(3072 + row) * 1024 + k] = f2bf(v);
      }
      return;
    }
    it -= 16;
  }
  transpose_tile(cx, p.w_out + (size_t)layer * 1024 * 1024, 1024, wout, (it >> 4) * 64, (it & 15) * 64, smem);
}

DI void phase0a(const Ctx& cx, const Params& p, char* smem) {
  const int tid = cx.tid;
  float* mod = (float*)(p.ws + OFF_MOD);
  const int nconv = convert_items(0);
  const int nitems = 384 + nconv + 1;
  bool sc_ready = false;
  float* sc = (float*)smem;
  float* red = (float*)(smem + 36864);
  for (int it = cx.bid; it < nitems; it += cx.nblk) {
    if (it < 384) {
      if (!sc_ready) {
        {
          float cv[36];
#pragma unroll
          for (int u = 0; u < 32; ++u) cv[u] = p.c[tid + 256 * u];
#pragma unroll
          for (int u = 0; u < 4; ++u) cv[32 + u] = p.c_ctx[tid + 256 * u];
#pragma unroll
          for (int u = 0; u < 36; ++u) sc[tid + 256 * u] = siluf(cv[u]);
        }
        sc_ready = true;
      }
      __syncthreads();
      const int layer = it / 96, col0 = (it % 96) * 32;
      const int c4 = tid & 7, kg = tid >> 3;
      const float* W = p.ada_w + (size_t)layer * 1024 * 3072 + col0 + c4 * 4;
      f32x4 acc[9];
#pragma unroll
      for (int c = 0; c < 9; ++c) acc[c] = (f32x4){0.f, 0.f, 0.f, 0.f};
      for (int i0 = 0; i0 < 32; i0 += 8) {
        f32x4 wv[8];
#pragma unroll
        for (int u = 0; u < 8; ++u) wv[u] = *(const f32x4*)(W + (size_t)(kg + 32 * (i0 + u)) * 3072);
#pragma unroll
        for (int u = 0; u < 8; ++u) {
          const int k = kg + 32 * (i0 + u);
#pragma unroll
          for (int c = 0; c < 9; ++c) { float s2 = sc[c * 1024 + k]; acc[c] += wv[u] * s2; }
        }
      }
#pragma unroll
      for (int c = 0; c < 9; ++c)
#pragma unroll
        for (int e = 0; e < 4; ++e) { float v = acc[c][e]; v += __shfl_xor(v, 8); v += __shfl_xor(v, 16); v += __shfl_xor(v, 32); acc[c][e] = v; }
      const int w = tid >> 6, lane = tid & 63;
      if (lane < 8) {
#pragma unroll
        for (int c = 0; c < 9; ++c)
#pragma unroll
          for (int e = 0; e < 4; ++e) red[(w * 9 + c) * 32 + lane * 4 + e] = acc[c][e];
      }
      __syncthreads();
      for (int o = tid; o < 9 * 32; o += 256) {
        int c = o >> 5, col = o & 31;
        float v = red[(0 * 9 + c) * 32 + col] + red[(1 * 9 + c) * 32 + col] + red[(2 * 9 + c) * 32 + col] + red[(3 * 9 + c) * 32 + col];
        v += p.ada_b[layer * 3072 + col0 + col];
        mod[((size_t)layer * 9 + c) * 3072 + col0 + col] = v;
      }
      __syncthreads();
    } else if (it < 384 + nconv) {
      __syncthreads();
      sc_ready = false;
      convert_item(cx, p, 0, it - 384, smem);
    } else {
      float* rc = (float*)(p.ws + OFF_ROPE); float* rs = rc + 2048;
      for (int i = tid; i < 2048; i += 256) {
        int pos = i >> 5, q = i & 31;
        float inv = __builtin_amdgcn_exp2f(-(float)q * (13.287712379549449f / 32.f));
        float rev = (float)pos * inv * 0.15915494309189535f;
        rc[i] = __builtin_amdgcn_cosf(rev); rs[i] = __builtin_amdgcn_sinf(rev);
      }
    }
  }
}

DI const float* resid_in(const Params& p, int layer, int b, int pos) {
  if (pos < CTXL) return (layer == 0 ? p.ctx : (const float*)(p.ws + OFF_XCTX)) + ((size_t)b * CTXL + pos) * D;
  return (layer == 0 ? p.x : (const float*)p.out) + ((size_t)b * SEQ + (pos - CTXL)) * D;
}
DI float* resid_out(const Params& p, int b, int pos) {
  if (pos < CTXL) return (float*)(p.ws + OFF_XCTX) + ((size_t)b * CTXL + pos) * D;
  return p.out + ((size_t)b * SEQ + (pos - CTXL)) * D;
}

DI void phase0b(const Ctx& cx, const Params& p) {
  const int lane = cx.tid & 63, wg = (cx.bid * 256 + cx.tid) >> 6, nw = cx.nblk * 4;
  const float* mod = (const float*)(p.ws + OFF_MOD);
  u16* H = (u16*)(p.ws + OFF_R0);
  for (int m0 = wg; m0 < MROWS; m0 += 2 * nw) {
    f32x4 xv[2][4], sh[2][4], sc[2][4];
#pragma unroll
    for (int q = 0; q < 2; ++q) {
      const int m = m0 + q * nw;
      if (m < MROWS) {
        const int b = m / LSEQ, pos = m % LSEQ;
        const float* xr = resid_in(p, 0, b, pos);
        const float* md = mod + (size_t)(0 * 9 + (pos < CTXL ? 8 : b)) * 3072;
#pragma unroll
        for (int i = 0; i < 4; ++i) { const int c = 4 * lane + 256 * i; xv[q][i] = *(const f32x4*)(xr + c); sh[q][i] = *(const f32x4*)(md + c); sc[q][i] = *(const f32x4*)(md + 1024 + c); }
      }
    }
#pragma unroll
    for (int q = 0; q < 2; ++q) {
      const int m = m0 + q * nw;
      if (m >= MROWS) continue;
#pragma unroll
      for (int i = 0; i < 4; ++i) {
        const int c = 4 * lane + 256 * i;
        f32x4 h = xv[q][i] * (sc[q][i] + 1.f) + sh[q][i];
        u32x2 o = {pk2(h[0], h[1]), pk2(h[2], h[3])};
        *(u32x2*)(H + (size_t)m * D + c) = o;
      }
    }
  }
}

DI void gemm_tile(const Ctx& cx, const u16* __restrict__ A, const u16* __restrict__ Bt, int row0, int col0, char* smem, f32x4 (&acc)[4][8]) {
  const int tid = cx.tid, lane = tid & 63, w = tid >> 6, wm = w >> 1, wn = w & 1, l15 = lane & 15, g = lane >> 4;
  const char* Abase = (const char*)(A + (size_t)row0 * 1024);
  const char* Bbase = (const char*)(Bt + (size_t)col0 * 1024);
  unsigned voA[4], voB[2];
#pragma unroll
  for (int i = 0; i < 4; ++i) { const int row = w * 64 + i * 16 + (lane >> 2), ch = (lane & 3) ^ ((-(row >> 2)) & 3); voA[i] = (unsigned)(row * 2048 + ch * 16); }
#pragma unroll
  for (int i = 0; i < 2; ++i) {
    const int row = w * 32 + i * 16 + (lane >> 2), ch = (lane & 3) ^ ((-(row >> 2)) & 3);
    const int r32 = row & 31, grow = (row & ~31) + 8 * ((r32 & 15) >> 2) + 4 * (r32 >> 4) + (r32 & 3);
    voB[i] = (unsigned)(grow * 2048 + ch * 16); }
  const int lA = w * 4096 + lane * 16, lB = 16384 + w * 2048 + lane * 16;
  const unsigned fo = (unsigned)(size_t)smem + l15 * 64 + ((g ^ ((-(l15 >> 2)) & 3)) << 4);
  const unsigned xbase = fo + 16384 + wn * 4096, ybase = fo + wm * 8192;
#pragma unroll
  for (int i = 0; i < 4; ++i)
#pragma unroll
    for (int j = 0; j < 8; ++j) acc[i][j] = (f32x4){0.f, 0.f, 0.f, 0.f};
#define GL_STAGE(kt_, so_) do { const char* ak_ = Abase + (kt_) * 64; const char* bk_ = Bbase + (kt_) * 64; char* sb_ = smem + (so_); \
    _Pragma("unroll") for (int i = 0; i < 4; ++i) { asm volatile("" : "+v"(voA[i]));   \
      __builtin_amdgcn_global_load_lds((const unsigned*)(ak_ + voA[i]), (unsigned*)(sb_ + lA + i * 1024), 16, 0, 0); } \
    _Pragma("unroll") for (int i = 0; i < 2; ++i) { asm volatile("" : "+v"(voB[i])); \
      __builtin_amdgcn_global_load_lds((const unsigned*)(bk_ + voB[i]), (unsigned*)(sb_ + lB + i * 1024), 16, 0, 0); } } while (0)
#define GL_STAGE_A(kt_, so_) do { const char* ak_ = Abase + (kt_) * 64; char* sb_ = smem + (so_); \
    _Pragma("unroll") for (int i = 0; i < 4; ++i) { asm volatile("" : "+v"(voA[i])); \
      __builtin_amdgcn_global_load_lds((const unsigned*)(ak_ + voA[i]), (unsigned*)(sb_ + lA + i * 1024), 16, 0, 0); } } while (0)
#define GL_STAGE_B(kt_, so_) do { const char* bk_ = Bbase + (kt_) * 64; char* sb_ = smem + (so_); \
    _Pragma("unroll") for (int i = 0; i < 2; ++i) { asm volatile("" : "+v"(voB[i])); \
      __builtin_amdgcn_global_load_lds((const unsigned*)(bk_ + voB[i]), (unsigned*)(sb_ + lB + i * 1024), 16, 0, 0); } } while (0)
#define DS_RD(dst, addr, off) asm volatile("ds_read_b128 %0, %1 offset:%2" : "=v"(dst) : "v"(addr), "n"(off))
  GL_STAGE(0, 0); GL_STAGE(1, 24576);
  if (cx.bid & 256) __builtin_amdgcn_s_sleep(10);
  int sc = 0;
  for (int kt = 0; kt < 32; ++kt) {
    if (kt < 31) asm volatile("s_waitcnt vmcnt(6)" ::: "memory");
    else asm volatile("s_waitcnt vmcnt(0)" ::: "memory");
    __builtin_amdgcn_s_barrier();
    const int sn = sc == 0 ? 49152 : sc - 24576;
    const unsigned xa = xbase + sc, ya = ybase + sc;
    bf16x8 xf[4], yf[8];
    DS_RD(xf[0], xa, 0); DS_RD(xf[1], xa, 1024); DS_RD(xf[2], xa, 2048); DS_RD(xf[3], xa, 3072);
    DS_RD(yf[0], ya, 0); DS_RD(yf[1], ya, 1024); DS_RD(yf[2], ya, 2048); DS_RD(yf[3], ya, 3072);
    DS_RD(yf[4], ya, 4096); DS_RD(yf[5], ya, 5120); DS_RD(yf[6], ya, 6144); DS_RD(yf[7], ya, 7168);
    if (kt + 2 < 32) GL_STAGE_A(kt + 2, sn);
    asm volatile("s_waitcnt lgkmcnt(4)" : "+v"(xf[0]), "+v"(xf[1]), "+v"(xf[2]), "+v"(xf[3]), "+v"(yf[0]), "+v"(yf[1]), "+v"(yf[2]), "+v"(yf[3]) :: "memory");
    __builtin_amdgcn_sched_barrier(0);
#pragma unroll
    for (int i = 0; i < 4; ++i)
#pragma unroll
      for (int j = 0; j < 4; ++j) acc[i][j] = mfma16(xf[i], yf[j], acc[i][j]);
    __builtin_amdgcn_sched_barrier(0);
    if (kt + 2 < 32) GL_STAGE_B(kt + 2, sn);
    asm volatile("s_waitcnt lgkmcnt(0)" : "+v"(yf[4]), "+v"(yf[5]), "+v"(yf[6]), "+v"(yf[7]) :: "memory");
    __builtin_amdgcn_sched_barrier(0);
#pragma unroll
    for (int i = 0; i < 4; ++i)
#pragma unroll
      for (int j = 4; j < 8; ++j) acc[i][j] = mfma16(xf[i], yf[j], acc[i][j]);
    __builtin_amdgcn_sched_barrier(0);
    sc = sc == 49152 ? 0 : sc + 24576;
  }
#undef GL_STAGE
#undef GL_STAGE_A
#undef GL_STAGE_B
#undef DS_RD
  __builtin_amdgcn_s_barrier();
}

DI void store_T(const Ctx& cx, const f32x4 (&acc)[4][8], u16* dst, int ld, int row0, int fcol0, float scale, char* smem) {
  const int lane = cx.tid & 63, w = cx.tid >> 6, wm = w >> 1, wn = w & 1, l15 = lane & 15, g = lane >> 4;
  char* img = smem + w * 18432;
#pragma unroll
  for (int yj = 0; yj < 8; ++yj)
#pragma unroll
    for (int xp = 0; xp < 2; ++xp) {
      f32x4 v0 = acc[2 * xp][yj] * scale, v1 = acc[2 * xp + 1][yj] * scale;
      u32x4 o = {pk2(v0[0], v0[1]), pk2(v0[2], v0[3]), pk2(v1[0], v1[1]), pk2(v1[2], v1[3])};
      *(u32x4*)(img + (yj * 16 + l15) * 144 + xp * 64 + 16 * g) = o;
    }
  __builtin_amdgcn_fence(__ATOMIC_RELEASE, "wavefront");
  asm volatile("s_waitcnt lgkmcnt(0)" ::: "memory");
  char* base = (char*)(dst + (size_t)(row0 + wm * 128) * ld + fcol0 + wn * 64) + (lane & 7) * 16;
  const int tr = lane >> 3;
#pragma unroll
  for (int k = 0; k < 16; ++k) {
    const int t = 8 * k + tr;
    u32x4 v = *(const u32x4*)(img + t * 144 + (lane & 7) * 16);
    *(u32x4*)(base + (size_t)((unsigned)(t * ld) * 2u)) = v;
  }
  __syncthreads();
}
DI void store_VT(const Ctx& cx, const f32x4 (&acc)[4][8], u16* vt, int b, int pos0, int fcol0, char* smem) {
  const int tid = cx.tid, lane = tid & 63, w = tid >> 6, wm = w >> 1, wn = w & 1, l15 = lane & 15, g = lane >> 4;
#pragma unroll
  for (int xi = 0; xi < 4; ++xi)
#pragma unroll
    for (int yj = 0; yj < 8; ++yj) {
      const unsigned p01 = pk2(acc[xi][yj][0], acc[xi][yj][1]), p23 = pk2(acc[xi][yj][2], acc[xi][yj][3]);
      const int f = wn * 64 + (xi >> 1) * 32 + 8 * g + 4 * (xi & 1), t = wm * 128 + yj * 16 + l15;
      char* d = smem + f * 528 + t * 2;
      *(u16*)(d) = (u16)(p01 & 0xffffu); *(u16*)(d + 528) = (u16)(p01 >> 16);
      *(u16*)(d + 1056) = (u16)(p23 & 0xffffu); *(u16*)(d + 1584) = (u16)(p23 >> 16);
    }
  __syncthreads();
#pragma unroll
  for (int i = 0; i < 16; ++i) {
    const int c = tid + 256 * i, f = c >> 5, tc = c & 31;
    u32x4 v = *(const u32x4*)(smem + f * 528 + tc * 16);
    *(u32x4*)(vt + (size_t)((unsigned)((b * 1024 + fcol0 + f) * LSEQ + pos0 + tc * 8))) = v;
  }
  __syncthreads();
}

DI void gemm_phase(const Ctx& cx, const Params& p, int kind, int layer, char* smem) {
  const int NC = kind == 0 ? 25 : (kind == 1 ? 32 : 8);
  const u16* A = (const u16*)(p.ws + OFF_R0);
  const u16* Bt = (const u16*)(p.ws + (kind == 2 ? OFF_WOUT : OFF_WIN));
  const bool last = (layer == 3);
  const int nitems = 72 * NC;
  for (int it = cx.bid; it < nitems; it += cx.nblk) {
    const int xcd = it & 7, j = it >> 3;
    const int grp = j / 72, rem = j - grp * 72, gw = min(8, NC - grp * 8);
    const int rt = (rem / gw) * 8 + xcd, ct = grp * 8 + rem % gw;
    const int b = rt / 9, pos0 = (rt % 9) * 256, row0 = rt * 256, col0 = ct * 128;
    const bool isctx = pos0 < CTXL;
    if (kind == 1) { if (last && isctx && (ct < 8 || ct >= 24)) continue; }
    else if (kind == 2) { if (last && isctx) continue; }
    f32x4 acc[4][8];
    gemm_tile(cx, A, Bt, row0, col0, smem, acc);
    Ctx cx2 = cx; asm volatile("" : "+v"(cx2.tid));
    if (kind == 0) {
      if (ct < 8) store_T(cx2, acc, (u16*)(p.ws + OFF_R1), 1024, row0, col0, ct < 4 ? 0.08838834764831845f : 1.f, smem);
      else if (ct < 16) store_VT(cx2, acc, (u16*)(p.ws + OFF_R3), b, pos0, col0 - 1024, smem);
      else if (ct < 24) store_T(cx2, acc, (u16*)(p.ws + OFF_R4), 1024, row0, col0 - 2048, 1.f, smem);
      else {
        const int lane = cx2.tid & 63, w = cx2.tid >> 6, wm = w >> 1, wn = w & 1, l15 = lane & 15, g = lane >> 4;
        u16* low = (u16*)(p.ws + OFF_LOW);
        if (wn == 0) {
#pragma unroll
          for (int yj = 0; yj < 8; ++yj) {
            const unsigned token = row0 + wm * 128 + yj * 16 + l15;
            f32x4 v0 = acc[0][yj], v1 = acc[1][yj];
            u32x4 o = {pk2(v0[0], v0[1]), pk2(v0[2], v0[3]), pk2(v1[0], v1[1]), pk2(v1[2], v1[3])};
            *(u32x4*)(low + (size_t)(token * 32u + 8 * g)) = o;
          }
        }
      }
    } else if (kind == 1) {
      if (ct < 8) store_T(cx2, acc, (u16*)(p.ws + OFF_R1), 1024, row0, col0, 0.125f * 1.4426950408889634f, smem);
      else if (ct < 16) store_T(cx2, acc, (u16*)(p.ws + OFF_R2), 1024, row0, col0 - 1024, 1.f, smem);
      else if (ct < 24) store_VT(cx2, acc, (u16*)(p.ws + OFF_R3), b, pos0, col0 - 2048, smem);
      else store_T(cx2, acc, (u16*)(p.ws + OFF_R4), 1024, row0, col0 - 3072, 1.f, smem);
    } else {
      store_T(cx2, acc, (u16*)(p.ws + OFF_R2), 1024, row0, col0, 1.f, smem);
    }
  }
}

DI void gla_prep_phase(const Ctx& cx, const Params& p, int layer, char* smem) {
  const int tid = cx.tid, lane = tid & 63, w = tid >> 6, l15 = lane & 15, g = lane >> 4;
  const int jl = layer >> 1;
  char* qS = smem; char* kS = smem + 16384;
  float* lowS = (float*)(smem + 32768);
  float* totS = (float*)(smem + 32768 + 4096);
  const u16* QK = (const u16*)(p.ws + OFF_R1);
  const u16* LOW = (const u16*)(p.ws + OFF_LOW);
  u16* QT = (u16*)(p.ws + OFF_R2); u16* KE = (u16*)(p.ws + OFF_R5); u16* ATT = (u16*)(p.ws + OFF_R6);
  float* DEC = (float*)(p.ws + OFF_DEC);
  const float* ropeC = (const float*)(p.ws + OFF_ROPE); const float* ropeS = ropeC + 2048;
  const int d6 = tid & 63, tq = tid >> 6;
  float* ropeL = (float*)(smem + 40960);
  {
    u32x4 rv[4];
#pragma unroll
    for (int u = 0; u < 4; ++u) rv[u] = *(const u32x4*)(ropeC + (tid + 256 * u) * 4);
#pragma unroll
    for (int u = 0; u < 4; ++u) *(u32x4*)(ropeL + (tid + 256 * u) * 4) = rv[u];
  }
  for (int it = cx.bid; it < NB * NCHUNK * 8; it += cx.nblk) {
    const int dir = it & 1, h = (it >> 1) & 3, bn = it >> 3, n = bn % NCHUNK, b = bn / NCHUNK;
    const size_t m0 = (size_t)b * LSEQ + n * 64;
    __syncthreads();
#pragma unroll
    for (int i = 0; i < 4; ++i) {
      int c = tid + 256 * i, row = c >> 4, ch = c & 15;
      u32x4 vq = *(const u32x4*)(QK + (m0 + row) * 1024 + h * 128 + ch * 8);
      u32x4 vk = *(const u32x4*)(QK + (m0 + row) * 1024 + 512 + h * 128 + ch * 8);
      int o = row * 256 + ((ch ^ (row & 15)) << 4);
      *(u32x4*)(qS + o) = vq; *(u32x4*)(kS + o) = vk;
    }
#pragma unroll
    for (int i = 0; i < 4; ++i) {
      int idx = tid + 256 * i, t = idx >> 4, r = idx & 15;
      lowS[idx] = bf2f(LOW[(m0 + t) * 32 + dir * 16 + r]);
    }
    float w2a[16], w2b[16];
    const float* w2 = p.gla_dec_w2 + ((size_t)(jl * 2 + dir) * 16) * 512 + h * 128 + d6;
#pragma unroll
    for (int r = 0; r < 16; ++r) { w2a[r] = w2[r * 512]; w2b[r] = w2[r * 512 + 64]; }
    const float ba = p.gla_dec_b[(jl * 2 + dir) * 512 + h * 128 + d6], bb = p.gla_dec_b[(jl * 2 + dir) * 512 + h * 128 + d6 + 64];
    __syncthreads();
    float la0[16], la1[16];
    float s0 = 0.f, s1 = 0.f;
#pragma unroll
    for (int tt = 0; tt < 16; ++tt) {
      const int t = tq * 16 + tt;
      float x0 = ba, x1 = bb;
#pragma unroll
      for (int r4 = 0; r4 < 4; ++r4) {
        f32x4 lv = *(const f32x4*)(lowS + t * 16 + r4 * 4);
#pragma unroll
        for (int e = 0; e < 4; ++e) { x0 += lv[e] * w2a[r4 * 4 + e]; x1 += lv[e] * w2b[r4 * 4 + e]; }
      }
      float l0 = (fminf(x0, 0.f) - __logf(1.f + __expf(-fabsf(x0)))) * 0.0625f;
      float l1 = (fminf(x1, 0.f) - __logf(1.f + __expf(-fabsf(x1)))) * 0.0625f;
      la0[tt] = l0; la1[tt] = l1; s0 += l0; s1 += l1;
    }
    totS[tq * 128 + d6] = s0; totS[tq * 128 + d6 + 64] = s1;
    __syncthreads();
    float off0 = 0.f, off1 = 0.f, tot0 = 0.f, tot1 = 0.f;
#pragma unroll
    for (int q = 0; q < 4; ++q) {
      float a = totS[q * 128 + d6], bq = totS[q * 128 + d6 + 64];
      tot0 += a; tot1 += bq;
      bool inc = dir == 0 ? (q < tq) : (q > tq);
      if (inc) { off0 += a; off1 += bq; }
    }
    const float dec0 = __expf(tot0), dec1 = __expf(tot1);
    if (tq == 0) { DEC[(size_t)it * 128 + d6] = dec0; DEC[(size_t)it * 128 + d6 + 64] = dec1; }
    const bool do_rope = n >= 4;
    unsigned ke0[8], ke1[8];
    float run0 = 0.f, run1 = 0.f, keprev0 = 0.f, keprev1 = 0.f;
#pragma unroll
    for (int hb = 0; hb < 2; ++hb) {
      unsigned qv[8], kv[8]; float csv[8], snv[8];
#pragma unroll
      for (int t8 = 0; t8 < 8; ++t8) {
        const int tt = hb * 8 + t8, t = tq * 16 + tt;
        const int o0 = t * 256 + (((d6 >> 3) ^ tt) << 4) + (d6 & 7) * 2;
        const int o1 = t * 256 + ((((d6 >> 3) + 8) ^ tt) << 4) + (d6 & 7) * 2;
        qv[t8] = (unsigned)*(const u16*)(qS + o0) | ((unsigned)*(const u16*)(qS + o1) << 16);
        kv[t8] = (unsigned)*(const u16*)(kS + o0) | ((unsigned)*(const u16*)(kS + o1) << 16);
        const int pos = d6 < 32 ? (do_rope ? n - 4 : 0) : t;
        csv[t8] = ropeL[pos * 32 + (d6 & 31)]; snv[t8] = ropeL[2048 + pos * 32 + (d6 & 31)];
      }
      asm volatile("" ::: "memory");
#pragma unroll
      for (int t8 = 0; t8 < 8; ++t8) {
        const int tt = hb * 8 + t8, t = tq * 16 + tt;
        const float rp0 = run0, rp1 = run1;
        run0 += la0[tt]; run1 += la1[tt];
        const float c0 = dir == 0 ? off0 + run0 : off0 + (s0 - rp0), c1 = dir == 0 ? off1 + run1 : off1 + (s1 - rp1);
        const float qb0 = dir == 0 ? c0 : c0 - la0[tt], qb1 = dir == 0 ? c1 : c1 - la1[tt];
        const int o0 = t * 256 + (((d6 >> 3) ^ tt) << 4) + (d6 & 7) * 2;
        const int o1 = t * 256 + ((((d6 >> 3) + 8) ^ tt) << 4) + (d6 & 7) * 2;
        float q0 = bf_lo(qv[t8]), q1 = bf_hi(qv[t8]);
        float k0 = bf_lo(kv[t8]), k1 = bf_hi(kv[t8]);
        if (do_rope) {
          const float cs = csv[t8], sn = snv[t8];
          float a = q0 * cs - q1 * sn, bq = q0 * sn + q1 * cs; q0 = a; q1 = bq;
          a = k0 * cs - k1 * sn; bq = k0 * sn + k1 * cs; k0 = a; k1 = bq;
        }
        const float kt0 = k0 * __expf(-c0), kt1 = k1 * __expf(-c1);
        *(u16*)(qS + o0) = f2bf(q0 * __expf(qb0)); *(u16*)(qS + o1) = f2bf(q1 * __expf(qb1));
        *(u16*)(kS + o0) = f2bf(kt0); *(u16*)(kS + o1) = f2bf(kt1);
        const float e0 = kt0 * dec0, e1 = kt1 * dec1;
        if (tt & 1) { ke0[tt >> 1] = pk2(keprev0, e0); ke1[tt >> 1] = pk2(keprev1, e1); } else { keprev0 = e0; keprev1 = e1; }
      }
      asm volatile("" ::: "memory");
    }
    {
      char* kimg = smem + 57344;
      u32x4 a = {ke0[0], ke0[1], ke0[2], ke0[3]}, bq = {ke0[4], ke0[5], ke0[6], ke0[7]};
      *(u32x4*)(kimg + d6 * 128 + (((tq * 2) ^ (d6 & 7)) << 4)) = a; *(u32x4*)(kimg + d6 * 128 + (((tq * 2 + 1) ^ (d6 & 7)) << 4)) = bq;
      u32x4 c = {ke1[0], ke1[1], ke1[2], ke1[3]}, d = {ke1[4], ke1[5], ke1[6], ke1[7]};
      *(u32x4*)(kimg + (d6 + 64) * 128 + (((tq * 2) ^ (d6 & 7)) << 4)) = c; *(u32x4*)(kimg + (d6 + 64) * 128 + (((tq * 2 + 1) ^ (d6 & 7)) << 4)) = d;
    }
    __syncthreads();
#pragma unroll
    for (int i = 0; i < 4; ++i) {
      const int c = tid + 256 * i, row = c >> 3, ch = c & 7;
      u32x4 v = *(const u32x4*)(smem + 57344 + row * 128 + ((ch ^ (row & 7)) << 4));
      *(u32x4*)(KE + (size_t)it * 8192 + c * 8) = v;
    }
#pragma unroll
    for (int i = 0; i < 4; ++i) {
      int c = tid + 256 * i, row = c >> 4, ch = c & 15;
      u32x4 v = *(const u32x4*)(qS + row * 256 + ((ch ^ (row & 15)) << 4));
      *(u32x4*)(QT + (size_t)it * 8192 + c * 8) = v;
    }
    {
      f32x4 at[4];
#pragma unroll
      for (int st = 0; st < 4; ++st) at[st] = (f32x4){0.f, 0.f, 0.f, 0.f};
#pragma unroll
      for (int kk = 0; kk < 4; ++kk) {
        const int co = ((kk * 4 + g) ^ l15) << 4;
        bf16x8 qf = *(const bf16x8*)(qS + (16 * w + l15) * 256 + co);
#pragma unroll
        for (int st = 0; st < 4; ++st) {
          bf16x8 kf = *(const bf16x8*)(kS + (16 * st + l15) * 256 + co);
          at[st] = mfma16(kf, qf, at[st]);
        }
      }
      const int t = 16 * w + l15;
#pragma unroll
      for (int st = 0; st < 4; ++st) {
        float v[4];
#pragma unroll
        for (int jj = 0; jj < 4; ++jj) { int s = 16 * st + 4 * g + jj; bool keep = dir == 0 ? (s <= t) : (s > t); v[jj] = keep ? at[st][jj] : 0.f; }
        u32x2 o = {pk2(v[0], v[1]), pk2(v[2], v[3])};
        *(u32x2*)(ATT + (size_t)it * 4096 + t * 64 + 16 * st + 4 * g) = o;
      }
    }
  }
}

DI void gla_chain_phase(const Ctx& cx, const Params& p, char* smem) {
  const int tid = cx.tid, lane = tid & 63, w = tid >> 6, l15 = lane & 15, g = lane >> 4;
  char* qtS = smem; char* keS = smem + 16384; char* atS = smem + 32768; char* vtS = smem + 40960; float* decS = (float*)(smem + 49152);
  const u16* QT = (const u16*)(p.ws + OFF_R2); const u16* KE = (const u16*)(p.ws + OFF_R5); const u16* ATT = (const u16*)(p.ws + OFF_R6);
  const u16* VT = (const u16*)(p.ws + OFF_R3); const float* DEC = (const float*)(p.ws + OFF_DEC);
  const int sw7 = (l15 >> 1) & 7;
  for (int it = cx.bid; it < 256; it += cx.nblk) {
    const int sl = it & 3, dir = (it >> 2) & 1, h = (it >> 3) & 3, b = it >> 5;
    u16* O = (u16*)(p.ws + (dir == 0 ? OFF_R1 : OFF_R0));
    f32x4 S[8]; bf16x8 Sbf[4];
#pragma unroll
    for (int a = 0; a < 8; ++a) S[a] = (f32x4){0.f, 0.f, 0.f, 0.f};
#pragma unroll
    for (int kk = 0; kk < 4; ++kk) Sbf[kk] = (bf16x8){0, 0, 0, 0, 0, 0, 0, 0};
    u32x4 pf[12]; f32x4 pfd = {0.f, 0.f, 0.f, 0.f};
    auto chunk_of = [&](int j) { return dir == 0 ? j : (j < 4 ? 3 - j : 39 - j); };
    auto issue = [&](int j) {
      const int n = chunk_of(j);
      const size_t pi = ((size_t)(b * NCHUNK + n) * 4 + h) * 2 + dir;
      const char* qb = (const char*)(QT + pi * 8192); const char* kb = (const char*)(KE + pi * 8192); const char* ab = (const char*)(ATT + pi * 4096);
      const char* vb = (const char*)(VT + ((size_t)b * 1024 + h * 256 + sl * 64) * LSEQ + n * 64);
      const unsigned lo = (unsigned)tid * 16u;
#pragma unroll
      for (int i = 0; i < 4; ++i) pf[i] = *(const u32x4*)(qb + lo + i * 4096);
#pragma unroll
      for (int i = 0; i < 4; ++i) pf[4 + i] = *(const u32x4*)(kb + lo + i * 4096);
#pragma unroll
      for (int i = 0; i < 2; ++i) pf[8 + i] = *(const u32x4*)(ab + lo + i * 4096);
#pragma unroll
      for (int i = 0; i < 2; ++i) { const unsigned c = tid + 256 * i, row = c >> 3, ch = c & 7; pf[10 + i] = *(const u32x4*)(vb + (row * LSEQ + ch * 8) * 2u); }
      if (tid < 32) pfd = *(const f32x4*)(DEC + pi * 128 + tid * 4);
    };
    auto commit = [&]() {
#pragma unroll
      for (int i = 0; i < 4; ++i) { int c = tid + 256 * i, row = c >> 4, ch = c & 15; *(u32x4*)(qtS + row * 256 + ((ch ^ (row & 15)) << 4)) = pf[i]; }
#pragma unroll
      for (int i = 0; i < 4; ++i) { int c = tid + 256 * i, row = c >> 3, ch = c & 7; *(u32x4*)(keS + row * 128 + ((ch ^ ((row >> 1) & 7)) << 4)) = pf[4 + i]; }
#pragma unroll
      for (int i = 0; i < 2; ++i) { int c = tid + 256 * i, row = c >> 3, ch = c & 7; *(u32x4*)(atS + row * 128 + ((ch ^ ((row >> 1) & 7)) << 4)) = pf[8 + i]; }
#pragma unroll
      for (int i = 0; i < 2; ++i) { int c = tid + 256 * i, row = c >> 3, ch = c & 7; *(u32x4*)(vtS + row * 128 + ((ch ^ ((row >> 1) & 7)) << 4)) = pf[10 + i]; }
      if (tid < 32) *(f32x4*)(decS + tid * 4) = pfd;
    };
    __syncthreads();
    issue(0); commit();
    __syncthreads();
    for (int j = 0; j < NCHUNK; ++j) {
      const int n = chunk_of(j);
      if (j + 1 < NCHUNK) issue(j + 1);
#define SB __builtin_amdgcn_sched_barrier(0)
#define LOADQ(QF, KK0) do { _Pragma("unroll") for (int k2 = 0; k2 < 2; ++k2) _Pragma("unroll") for (int tt = 0; tt < 4; ++tt) { \
        const int row = 16 * tt + l15; const int e0 = 32 * ((KK0) + k2) + 4 * g, e1 = e0 + 16; \
        u32x2 lo = *(const u32x2*)(qtS + row * 256 + (((e0 >> 3) ^ l15) << 4) + (e0 & 7) * 2); \
        u32x2 hi = *(const u32x2*)(qtS + row * 256 + (((e1 >> 3) ^ l15) << 4) + (e1 & 7) * 2); \
        u32x4 q4 = {lo[0], lo[1], hi[0], hi[1]}; QF[k2][tt] = __builtin_bit_cast(bf16x8, q4); } } while (0)
      bf16x8 vf[2], af[4][2];
#pragma unroll
      for (int kk = 0; kk < 2; ++kk) vf[kk] = *(const bf16x8*)(vtS + (16 * w + l15) * 128 + (((kk * 4 + g) ^ sw7) << 4));
#pragma unroll
      for (int tt = 0; tt < 4; ++tt)
#pragma unroll
        for (int kk = 0; kk < 2; ++kk) af[tt][kk] = *(const bf16x8*)(atS + (16 * tt + l15) * 128 + (((kk * 4 + g) ^ sw7) << 4));
      bf16x8 qa[2][4];
      LOADQ(qa, 0);
      SB;
      f32x4 o[4];
#pragma unroll
      for (int tt = 0; tt < 4; ++tt) {
        o[tt] = mfma16(vf[0], af[tt][0], (f32x4){0.f, 0.f, 0.f, 0.f});
        o[tt] = mfma16(vf[1], af[tt][1], o[tt]);
      }
      SB;
      bf16x8 qb[2][4];
      LOADQ(qb, 2);
      SB;
#pragma unroll
      for (int k2 = 0; k2 < 2; ++k2)
#pragma unroll
        for (int tt = 0; tt < 4; ++tt) o[tt] = mfma16(Sbf[k2], qa[k2][tt], o[tt]);
      SB;
#define LOADK(KF, DF, A0) do { _Pragma("unroll") for (int a = 0; a < 2; ++a) { DF[a] = *(const f32x4*)(decS + 16 * ((A0) + a) + 4 * g); \
        _Pragma("unroll") for (int kk = 0; kk < 2; ++kk) KF[a][kk] = *(const bf16x8*)(keS + (16 * ((A0) + a) + l15) * 128 + (((kk * 4 + g) ^ sw7) << 4)); } } while (0)
#define SUPD(KF, DF, A0) do { _Pragma("unroll") for (int a = 0; a < 2; ++a) { S[(A0) + a] *= DF[a]; \
        S[(A0) + a] = mfma16(KF[a][0], vf[0], S[(A0) + a]); S[(A0) + a] = mfma16(KF[a][1], vf[1], S[(A0) + a]); } } while (0)
      bf16x8 k0[2][2], k1[2][2]; f32x4 d0[2], d1[2];
      LOADK(k0, d0, 0);
      SB;
#pragma unroll
      for (int k2 = 0; k2 < 2; ++k2)
#pragma unroll
        for (int tt = 0; tt < 4; ++tt) o[tt] = mfma16(Sbf[2 + k2], qb[k2][tt], o[tt]);
      SB;
      LOADK(k1, d1, 2);
      SB;
      SUPD(k0, d0, 0);
      SB;
#pragma unroll
      for (int tt = 0; tt < 4; ++tt) {
        size_t m = (size_t)b * LSEQ + n * 64 + 16 * tt + l15;
        u32x2 ov = {pk2(o[tt][0], o[tt][1]), pk2(o[tt][2], o[tt][3])};
        *(u32x2*)(O + m * 1024 + h * 256 + sl * 64 + 16 * w + 4 * g) = ov;
      }
      LOADK(k0, d0, 4);
      SB;
      SUPD(k1, d1, 2);
      SB;
      LOADK(k1, d1, 6);
      SB;
      SUPD(k0, d0, 4);
      SB;
      SUPD(k1, d1, 6);
#undef LOADK
#undef SUPD
#undef SB
#undef LOADQ
#pragma unroll
      for (int kk = 0; kk < 4; ++kk) {
        u32x4 s4 = {pk2(S[2 * kk][0], S[2 * kk][1]), pk2(S[2 * kk][2], S[2 * kk][3]), pk2(S[2 * kk + 1][0], S[2 * kk + 1][1]), pk2(S[2 * kk + 1][2], S[2 * kk + 1][3])};
        Sbf[kk] = __builtin_bit_cast(bf16x8, s4);
      }
      __syncthreads();
      if (j + 1 < NCHUNK) { commit(); __syncthreads(); }
    }
  }
}

DI void gla_merge_phase(const Ctx& cx, const Params& p, int layer) {
  const int lane = cx.tid & 63, wg = (cx.bid * 256 + cx.tid) >> 6, nw = cx.nblk * 4;
  const u16* OF = (const u16*)(p.ws + OFF_R1); u16* OB = (u16*)(p.ws + OFF_R0); const u16* G = (const u16*)(p.ws + OFF_R4);
  const float* ng = p.gla_norm_g + (layer >> 1) * 256 + (lane & 15) * 16;
  float ngv[16];
#pragma unroll
  for (int i = 0; i < 16; ++i) ngv[i] = ng[i];
  for (int m0 = wg; m0 < MROWS; m0 += 2 * nw) {
    float o[2][16], gv[2][16];
#pragma unroll
    for (int q = 0; q < 2; ++q) {
      const int m = m0 + q * nw;
      if (m < MROWS) {
        const size_t base = (size_t)m * 1024 + lane * 16;
#pragma unroll
        for (int hlf = 0; hlf < 2; ++hlf) {
          u32x4 a = *(const u32x4*)(OF + base + hlf * 8), bq = *(const u32x4*)(OB + base + hlf * 8), c = *(const u32x4*)(G + base + hlf * 8);
#pragma unroll
          for (int e = 0; e < 4; ++e) {
            o[q][hlf * 8 + 2 * e] = bf_lo(a[e]) + bf_lo(bq[e]); o[q][hlf * 8 + 2 * e + 1] = bf_hi(a[e]) + bf_hi(bq[e]);
            gv[q][hlf * 8 + 2 * e] = bf_lo(c[e]); gv[q][hlf * 8 + 2 * e + 1] = bf_hi(c[e]);
          }
        }
      }
    }
#pragma unroll
    for (int q = 0; q < 2; ++q) {
      const int m = m0 + q * nw;
      if (m >= MROWS) continue;
      const size_t base = (size_t)m * 1024 + lane * 16;
      float ss = 0.f;
#pragma unroll
      for (int i = 0; i < 16; ++i) ss += o[q][i] * o[q][i];
      ss += __shfl_xor(ss, 1); ss += __shfl_xor(ss, 2); ss += __shfl_xor(ss, 4); ss += __shfl_xor(ss, 8);
      const float r = rsqrtf(ss * (1.f / 256.f) + 1e-6f);
      unsigned ov[8];
#pragma unroll
      for (int e = 0; e < 8; ++e) {
        float v0 = o[q][2 * e] * r * ngv[2 * e] * siluf(gv[q][2 * e]), v1 = o[q][2 * e + 1] * r * ngv[2 * e + 1] * siluf(gv[q][2 * e + 1]);
        ov[e] = pk2(v0, v1);
      }
      u32x4 w0 = {ov[0], ov[1], ov[2], ov[3]}, w1 = {ov[4], ov[5], ov[6], ov[7]};
      *(u32x4*)(OB + base) = w0; *(u32x4*)(OB + base + 8) = w1;
    }
  }
}

DI void ln_phase(const Ctx& cx, const Params& p, int layer, char* smem) {
  const int lane = cx.tid & 63, wg = (cx.bid * 256 + cx.tid) >> 6, nw = cx.nblk * 4;
  const float* mod = (const float*)(p.ws + OFF_MOD);
  const u16* Y = (const u16*)(p.ws + OFF_R2);
  u16* H = (u16*)(p.ws + OFF_R0);
  const bool last = layer == 3;
  f32x4 gg[4], bb[4];
#pragma unroll
  for (int i = 0; i < 4; ++i) { const int c = 4 * lane + 256 * i; gg[i] = *(const f32x4*)(p.ln_g + layer * 1024 + c); bb[i] = *(const f32x4*)(p.ln_b + layer * 1024 + c); }
  for (int m0 = wg; m0 < MROWS; m0 += 2 * nw) {
    float v[2][16]; f32x4 shn[2][4], scn[2][4];
    float sum[2] = {0.f, 0.f};
    bool act[2];
#pragma unroll
    for (int q = 0; q < 2; ++q) {
      const int m = m0 + q * nw;
      const int b = m / LSEQ, pos = m % LSEQ;
      act[q] = (m < MROWS) && !(last && pos < CTXL);
      if (act[q]) {
        const int cond = pos < CTXL ? 8 : b;
        const float* xr = resid_in(p, layer, b, pos);
        const float* md = mod + (size_t)(layer * 9 + cond) * 3072;
        const float* mdn = mod + (size_t)((layer + 1) * 9 + cond) * 3072;
#pragma unroll
        for (int i = 0; i < 4; ++i) {
          const int c = 4 * lane + 256 * i;
          f32x4 xv = *(const f32x4*)(xr + c), gt = *(const f32x4*)(md + 2048 + c);
          u32x2 yv = *(const u32x2*)(Y + (size_t)m * 1024 + c);
          if (!last) { shn[q][i] = *(const f32x4*)(mdn + c); scn[q][i] = *(const f32x4*)(mdn + 1024 + c); }
          v[q][4 * i + 0] = ALPHA * xv[0] + gt[0] * bf_lo(yv[0]); v[q][4 * i + 1] = ALPHA * xv[1] + gt[1] * bf_hi(yv[0]);
          v[q][4 * i + 2] = ALPHA * xv[2] + gt[2] * bf_lo(yv[1]); v[q][4 * i + 3] = ALPHA * xv[3] + gt[3] * bf_hi(yv[1]);
          sum[q] += v[q][4 * i] + v[q][4 * i + 1] + v[q][4 * i + 2] + v[q][4 * i + 3];
        }
      }
    }
#pragma unroll
    for (int q = 0; q < 2; ++q) {
      if (!act[q]) continue;
      const int m = m0 + q * nw;
      const int b = m / LSEQ, pos = m % LSEQ;
      float* xo = resid_out(p, b, pos);
      float sm = sum[q];
#pragma unroll
      for (int s2 = 1; s2 < 64; s2 <<= 1) sm += __shfl_xor(sm, s2);
      const float mu = sm * (1.f / 1024.f);
      float var = 0.f;
#pragma unroll
      for (int i = 0; i < 16; ++i) { float d = v[q][i] - mu; var += d * d; }
#pragma unroll
      for (int s2 = 1; s2 < 64; s2 <<= 1) var += __shfl_xor(var, s2);
      const float rstd = rsqrtf(var * (1.f / 1024.f) + 1e-5f);
#pragma unroll
      for (int i = 0; i < 4; ++i) {
        const int c = 4 * lane + 256 * i;
        f32x4 xn;
#pragma unroll
        for (int e = 0; e < 4; ++e) xn[e] = (v[q][4 * i + e] - mu) * rstd * gg[i][e] + bb[i][e];
        *(f32x4*)(xo + c) = xn;
        if (!last) {
          f32x4 hh = xn * (scn[q][i] + 1.f) + shn[q][i];
          u32x2 o = {pk2(hh[0], hh[1]), pk2(hh[2], hh[3])};
          *(u32x2*)(H + (size_t)m * 1024 + c) = o;
        }
      }
    }
  }
  if (!last) {
    const int nconv = convert_items(layer + 1);
    for (int it = cx.bid; it < nconv; it += cx.nblk) convert_item(cx, p, layer + 1, it, smem);
  }
}

DI void na_attn_phase(const Ctx& cx, const Params& p, int layer, char* smem) {
  const int tid = cx.tid, lane = tid & 63, w = tid >> 6, l15 = lane & 15, g = lane >> 4;
  const bool need_ctx = layer < 3;
  const int RPI = need_ctx ? 18 : 16;
  const u16* Q = (const u16*)(p.ws + OFF_R1); const u16* K = (const u16*)(p.ws + OFF_R2); const u16* VT = (const u16*)(p.ws + OFF_R3);
  const u16* G = (const u16*)(p.ws + OFF_R4); u16* MG = (u16*)(p.ws + OFF_R0);
  float* rpbS = (float*)(smem + 65536 + 64);
  const char* Qs = smem + 32768;
  const int sw7 = (l15 >> 1) & 7;
  const int nitems = NB * 16 * RPI;
  const int ws = w == 0 ? 0 : (w == 1 ? 8 : (w == 2 ? 24 : 32));
  const int qc = 16 * w + l15;
  const int cs = min(max(qc - 8, 0), 48);
  const int d0 = ws + 4 * g - cs;
  const int bi0 = ws + 4 * g - qc + 15;
  const int kls = ((ws + l15) >> 1) & 7;
  const int kL0 = (ws + l15) * 128 + ((g ^ kls) << 4), kL1 = (ws + l15) * 128 + (((4 + g) ^ kls) << 4);
  const int kC0 = l15 * 128 + ((g ^ sw7) << 4), kC1 = l15 * 128 + (((4 + g) ^ sw7) << 4);
  const int vL0 = l15 * 128 + ((((ws >> 3) + (g >> 1)) ^ sw7) << 4) + (g & 1) * 8, vL1 = l15 * 128 + ((((ws >> 3) + 2 + (g >> 1)) ^ sw7) << 4) + (g & 1) * 8;
  const int vC0 = l15 * 128 + (((g >> 1) ^ sw7) << 4) + (g & 1) * 8, vC1 = l15 * 128 + (((2 + (g >> 1)) ^ sw7) << 4) + (g & 1) * 8;
  const int vC2 = l15 * 128 + (((4 + (g >> 1)) ^ sw7) << 4) + (g & 1) * 8, vC3 = l15 * 128 + (((6 + (g >> 1)) ^ sw7) << 4) + (g & 1) * 8;
  for (int it = cx.bid; it < nitems; it += cx.nblk) {
    const int nlat = NB * 16 * 16;
    const int rg = it < nlat ? (it & 15) : 16 + ((it - nlat) & 1), bh = it < nlat ? (it >> 4) : ((it - nlat) >> 1), h = bh & 15, b = bh >> 4;
    const bool lat = rg < 16;
    const int r0 = rg * 2;
    const int ylo = lat ? min(max(r0 - 4, 0), 24) : 0;
    const int yhi = lat ? min(max(r0 + 1 - 4, 0), 24) + 7 : -1;
    const int nloc = yhi - ylo + 1;
    const int nst = nloc + 4;
    const int mbase = b * LSEQ + (lat ? CTXL + r0 * 64 : (rg - 16) * 128);
    __syncthreads();
    for (int i = tid; i < 465; i += 256) rpbS[i] = p.na_rpb[((size_t)(layer >> 1) * 16 + h) * 465 + i] * 1.4426950408889634f;
#pragma unroll
    for (int i = 0; i < 4; ++i) {
      const int c = tid + 256 * i, qrow = c >> 3, ch = c & 7;
      u32x4 v = *(const u32x4*)(Q + (unsigned)((mbase + qrow) * 1024 + h * 64 + ch * 8));
      *(u32x4*)(smem + 32768 + qrow * 128 + ((ch ^ ((qrow >> 1) & 7)) << 4)) = v;
    }
    auto issue = [&](int st, int buf) {
      const int p0 = st < nloc ? CTXL + (ylo + st) * 64 : (st - nloc) * 64;
#pragma unroll
      for (int i = 0; i < 2; ++i) {
        const int row = w * 16 + i * 8 + (lane >> 3), ch = (lane & 7) ^ ((row >> 1) & 7);
        __builtin_amdgcn_global_load_lds((const unsigned*)(K + (unsigned)((b * LSEQ + p0 + row) * 1024 + h * 64 + ch * 8)), (unsigned*)(smem + buf * 16384 + w * 2048 + i * 1024 + lane * 16), 16, 0, 0);
        const int r32 = row & 31, vrow = (row & ~31) + 8 * ((r32 & 15) >> 2) + 4 * (r32 >> 4) + (r32 & 3);
        __builtin_amdgcn_global_load_lds((const unsigned*)(VT + (unsigned)((b * 1024 + h * 64 + vrow) * LSEQ + p0 + ch * 8)), (unsigned*)(smem + buf * 16384 + 8192 + w * 2048 + i * 1024 + lane * 16), 16, 0, 0);
      }
    };
    issue(0, 0);
    __syncthreads();
    float mrun[2], lrun[2];
    f32x4 o[2][4];
#pragma unroll
    for (int rr = 0; rr < 2; ++rr) {
      mrun[rr] = -1e20f; lrun[rr] = 0.f;
#pragma unroll
      for (int dt = 0; dt < 4; ++dt) o[rr][dt] = (f32x4){0.f, 0.f, 0.f, 0.f};
    }
    auto block = [&](const char* Ks, const char* Vs, int k0off, int k1off, int v0off, int v1off, bool local, int y, int ist, int ibuf) {
#pragma unroll
      for (int pr = 0; pr < 1; ++pr) {
        bf16x8 kf[2][2];
#pragma unroll
        for (int kt = 0; kt < 2; ++kt) { kf[kt][0] = *(const bf16x8*)(Ks + k0off + kt * 2048); kf[kt][1] = *(const bf16x8*)(Ks + k1off + kt * 2048); }
        if (ist >= 0) issue(ist, ibuf);
        f32x4 sc[2][2];
#pragma unroll
        for (int q2 = 0; q2 < 2; ++q2) {
          const int rr = 2 * pr + q2;
          const bf16x8 qf0 = *(const bf16x8*)(Qs + rr * 8192 + w * 2048 + kC0), qf1 = *(const bf16x8*)(Qs + rr * 8192 + w * 2048 + kC1);
          const int r = r0 + rr;
          const int rs = min(max(r - 4, 0), 24);
          const bool active = (y >= rs) && (y < rs + 8);
          float bv[8];
          if (local) {
            const float* bp = rpbS + ((y - r + 7) * 31 + bi0);
#pragma unroll
            for (int kt = 0; kt < 2; ++kt)
#pragma unroll
              for (int jj = 0; jj < 4; ++jj) bv[kt * 4 + jj] = bp[16 * kt + jj];
            asm volatile("" : "+v"(bv[0]), "+v"(bv[1]), "+v"(bv[2]), "+v"(bv[3]), "+v"(bv[4]), "+v"(bv[5]), "+v"(bv[6]), "+v"(bv[7]));
          }
#pragma unroll
          for (int kt = 0; kt < 2; ++kt) {
            sc[q2][kt] = mfma16(kf[kt][0], qf0, (f32x4){0.f, 0.f, 0.f, 0.f});
            sc[q2][kt] = mfma16(kf[kt][1], qf1, sc[q2][kt]);
          }
          if (local) {
#pragma unroll
            for (int kt = 0; kt < 2; ++kt)
#pragma unroll
              for (int jj = 0; jj < 4; ++jj) {
                const bool valid = active && ((unsigned)(d0 + 16 * kt + jj) < 16u);
                sc[q2][kt][jj] = valid ? sc[q2][kt][jj] + bv[kt * 4 + jj] : -1e30f;
              }
          }
        }
        float mx[2];
        bool need = false;
#pragma unroll
        for (int q2 = 0; q2 < 2; ++q2) {
          float m = fmaxf(fmaxf(fmaxf(sc[q2][0][0], sc[q2][0][1]), fmaxf(sc[q2][0][2], sc[q2][0][3])), fmaxf(fmaxf(sc[q2][1][0], sc[q2][1][1]), fmaxf(sc[q2][1][2], sc[q2][1][3])));
          mx[q2] = m; need = need || (m > mrun[2 * pr + q2] + 8.f);
        }
        if (__builtin_amdgcn_ballot_w64(need) != 0ull) {
#pragma unroll
          for (int q2 = 0; q2 < 2; ++q2) {
            const int rr = 2 * pr + q2;
            float m = mx[q2];
            m = fmaxf(m, __shfl_xor(m, 16)); m = fmaxf(m, __shfl_xor(m, 32));
            const float mnew = fmaxf(mrun[rr], m);
            const float alpha = __builtin_amdgcn_exp2f(mrun[rr] - mnew);
            mrun[rr] = mnew; lrun[rr] *= alpha;
#pragma unroll
            for (int dt = 0; dt < 4; ++dt) o[rr][dt] *= alpha;
          }
        }
        bf16x8 pfrag[2];
#pragma unroll
        for (int q2 = 0; q2 < 2; ++q2) {
          const int rr = 2 * pr + q2;
          const float mcur = mrun[rr];
          float ps = 0.f;
#pragma unroll
          for (int kt = 0; kt < 2; ++kt)
#pragma unroll
            for (int jj = 0; jj < 4; ++jj) { float e = __builtin_amdgcn_exp2f(sc[q2][kt][jj] - mcur); sc[q2][kt][jj] = e; ps += e; }
          lrun[rr] += ps;
          u32x4 p4 = {pk2(sc[q2][0][0], sc[q2][0][1]), pk2(sc[q2][0][2], sc[q2][0][3]), pk2(sc[q2][1][0], sc[q2][1][1]), pk2(sc[q2][1][2], sc[q2][1][3])};
          pfrag[q2] = __builtin_bit_cast(bf16x8, p4);
        }
#pragma unroll
        for (int dt = 0; dt < 4; ++dt) {
          u32x2 lo = *(const u32x2*)(Vs + v0off + dt * 2048);
          u32x2 hi = *(const u32x2*)(Vs + v1off + dt * 2048);
          u32x4 v4 = {lo[0], lo[1], hi[0], hi[1]};
          const bf16x8 vf = __builtin_bit_cast(bf16x8, v4);
#pragma unroll
          for (int q2 = 0; q2 < 2; ++q2) o[2 * pr + q2][dt] = mfma16(vf, pfrag[q2], o[2 * pr + q2][dt]);
        }
        __builtin_amdgcn_sched_barrier(0);
      }
    };
    for (int st = 0; st < nst; ++st) {
      const int buf = st & 1;
      const char* Ks = smem + buf * 16384; const char* Vs = Ks + 8192;
      const int ist = st + 1 < nst ? st + 1 : -1;
      if (st < nloc) {
        block(Ks, Vs, kL0, kL1, vL0, vL1, true, ylo + st, ist, buf ^ 1);
      } else {
        block(Ks, Vs, kC0, kC1, vC0, vC1, false, 0, ist, buf ^ 1);
        __builtin_amdgcn_sched_barrier(0);
        block(Ks, Vs, kC0 + 4096, kC1 + 4096, vC2, vC3, false, 0, -1, 0);
      }
      __syncthreads();
    }
#pragma unroll
    for (int rr = 0; rr < 2; ++rr) {
      float l = lrun[rr];
      l += __shfl_xor(l, 16); l += __shfl_xor(l, 32);
      const float inv = __builtin_amdgcn_rcpf(l);
#pragma unroll
      for (int dp = 0; dp < 2; ++dp) {
        const unsigned a = (unsigned)((mbase + rr * 64 + 16 * w + l15) * 1024 + h * 64 + dp * 32 + 8 * g);
        u32x4 gv = *(const u32x4*)(G + a);
        const f32x4 oa = o[rr][2 * dp] * inv, ob = o[rr][2 * dp + 1] * inv;
        u32x4 ov = {pk2(oa[0] * siluf(bf_lo(gv[0])), oa[1] * siluf(bf_hi(gv[0]))), pk2(oa[2] * siluf(bf_lo(gv[1])), oa[3] * siluf(bf_hi(gv[1]))),
                    pk2(ob[0] * siluf(bf_lo(gv[2])), ob[1] * siluf(bf_hi(gv[2]))), pk2(ob[2] * siluf(bf_lo(gv[3])), ob[3] * siluf(bf_hi(gv[3])))};
        *(u32x4*)(MG + a) = ov;
      }
    }
  }
}

#define XB_TMO      128
#define XB_XCNT(j)  (256  + 64 * (j))
#define XB_XSUB(j)  (1280 + 64 * (j))
#define XB_XGEN(j)  (2304 + 64 * (j))
#define XB_TOP      3328
#define XB_TOPGEN   3392
#define XCD_BAR_WORDS 3456
#define XB_SPIN_CAP (1u << 22)
#define LAS __attribute__((address_space(3)))
DI unsigned xb_ld(unsigned* p)              { return __hip_atomic_load(p, __ATOMIC_RELAXED, __HIP_MEMORY_SCOPE_AGENT); }
DI unsigned xb_add(unsigned* p, unsigned v) { return __hip_atomic_fetch_add(p, v, __ATOMIC_RELAXED, __HIP_MEMORY_SCOPE_AGENT); }
DI unsigned xb_xcc_id() { return (unsigned)__builtin_amdgcn_s_getreg((3 << 11) | 20) & 0xFu; }
#define XB_SPIN(cond, bar) do { unsigned _sp = 0; while (cond) { __builtin_amdgcn_s_sleep(1); \
    if ((++_sp & 255u) == 0u) { if (xb_ld(&(bar)[XB_TMO])) break; if (_sp > XB_SPIN_CAP) { atomicAdd(&(bar)[XB_TMO], 1u); break; } } } } while (0)
struct XcdBarrier { unsigned* bar; unsigned x; volatile LAS unsigned* st; };
DI XcdBarrier xcd_barrier_post(unsigned* bar, volatile LAS unsigned* st) {
  XcdBarrier b; b.bar = bar; b.x = xb_xcc_id(); b.st = st;
  if (threadIdx.x == 0) (void)xb_add(&bar[XB_XCNT(b.x)], 1u);
  return b;
}
DI void xcd_barrier_complete(unsigned* bar, unsigned x, unsigned& nloc, unsigned& nx) {
  const unsigned G = gridDim.x * gridDim.y * gridDim.z;
  unsigned sum, cnt, mine, sp = 0u;
  for (;;) {
    sum = 0u; cnt = 0u; mine = 0u;
#pragma unroll
    for (unsigned j = 0; j < 16; ++j) { const unsigned c = xb_ld(&bar[XB_XCNT(j)]); sum += c; cnt += (c > 0u) ? 1u : 0u; mine = (j == x) ? c : mine; }
    if (sum == G) break;
    __builtin_amdgcn_s_sleep(1);
    if ((++sp & 255u) == 0u) { if (xb_ld(&bar[XB_TMO])) break; if (sp > XB_SPIN_CAP) { atomicAdd(&bar[XB_TMO], 1u); break; } }
  }
  nloc = mine > 0u ? mine : 1u; nx = cnt > 0u ? cnt : 1u;
}
DI void xcd_barrier(const XcdBarrier& b) {
  asm volatile("s_waitcnt vmcnt(0)" ::: "memory");
  __syncthreads();
  if (threadIdx.x == 0) {
    unsigned* bar = b.bar;
    __builtin_amdgcn_s_waitcnt(0);
    unsigned nloc = b.st[0], nx = b.st[1];
    if (nloc == 0u) { xcd_barrier_complete(bar, b.x, nloc, nx); b.st[0] = nloc; b.st[1] = nx; }
    const unsigned old = xb_add(&bar[XB_XSUB(b.x)], 1u);
    const unsigned gen = old / nloc;
    if (old + 1u == (gen + 1u) * nloc) {
      __builtin_amdgcn_fence(__ATOMIC_RELEASE, "agent");
      asm volatile("s_waitcnt vmcnt(0)" ::: "memory");
      const unsigned og = xb_add(&bar[XB_TOP], 1u);
      const unsigned tg = og / nx;
      if (og + 1u == (tg + 1u) * nx) xb_add(&bar[XB_TOPGEN], 1u);
      else XB_SPIN(xb_ld(&bar[XB_TOPGEN]) == tg, bar);
      __builtin_amdgcn_fence(__ATOMIC_ACQUIRE, "agent");
      xb_add(&bar[XB_XGEN(b.x)], 1u);
      asm volatile("s_waitcnt vmcnt(0)" ::: "memory");
    } else {
      XB_SPIN(xb_ld(&bar[XB_XGEN(b.x)]) == gen, bar);
      __builtin_amdgcn_fence(__ATOMIC_ACQUIRE, "agent");
      asm volatile("s_waitcnt vmcnt(0)" ::: "memory");
    }
  }
  __syncthreads();
}

constexpr int NPHASES = 22;
constexpr int SMEM_BYTES = 79872;
__global__ void __launch_bounds__(256, 2) fwd_megakernel(Params p) {
  __shared__ __attribute__((aligned(16))) char smem[SMEM_BYTES];
  cg::grid_group grid = cg::this_grid();
  __shared__ uint4 xb_words;
  if (threadIdx.x == 0) xb_words = make_uint4(0u, 0u, 0u, 0u);
  __syncthreads();
  XcdBarrier xb = xcd_barrier_post((unsigned*)(p.ws + OFF_BAR), (volatile LAS unsigned*)&xb_words);
  const int wave_id = __builtin_amdgcn_readfirstlane((int)(threadIdx.x >> 6));
  for (int ph = p.ph_lo; ph < p.ph_hi; ++ph) {
    Ctx cx; cx.tid = wave_id * 64 + (int)__builtin_amdgcn_mbcnt_hi(~0u, __builtin_amdgcn_mbcnt_lo(~0u, 0u)); cx.bid = blockIdx.x; cx.nblk = gridDim.x;
    asm volatile("" : "+v"(cx.tid)); asm volatile("" : "+s"(cx.bid)); asm volatile("" : "+s"(cx.nblk));
    Params pp = p;
    asm volatile("" : "+s"(pp.ws)); asm volatile("" : "+s"(pp.out));
    if (ph == 0) phase0a(cx, pp, smem);
    else if (ph == 1) phase0b(cx, pp);
    else {
      const int q = ph - 2, pair = q / 10, r = q % 10;
      const int layer = 2 * pair + (r >= 6 ? 1 : 0);
      int gk = -1;
      if (r == 0) gk = 0; else if (r == 6) gk = 1; else if (r == 4 || r == 8) gk = 2;
      asm volatile("" : "+s"(gk));
      if (gk >= 0) { for (int rep = 0; rep < (gk == 2 ? REP_GOUT : REP_GIN); ++rep) gemm_phase(cx, pp, gk, layer, smem); }
      else if (r == 5 || r == 9) ln_phase(cx, pp, layer, smem);
      else if (r == 1) { for (int rep = 0; rep < REP_PREP; ++rep) gla_prep_phase(cx, pp, layer, smem); }
      else if (r == 2) { for (int rep = 0; rep < REP_CHAIN; ++rep) gla_chain_phase(cx, pp, smem); }
      else if (r == 3) gla_merge_phase(cx, pp, layer);
      else { for (int rep = 0; rep < REP_NA; ++rep) na_attn_phase(cx, pp, layer, smem); }
    }
    if (ph + 1 < p.ph_hi) { if (p.ph_hi > NPHASES) grid.sync(); else xcd_barrier(xb); }
  }
}

extern "C" void kernel_launch(void* const* d_in, const int* in_sizes, int n_in, void* d_out, int out_size, void* d_ws, size_t ws_size, hipStream_t stream) {
  static int grid_blocks = 0;
  if (!grid_blocks) {
    int dev = 0, cus = 0, per_cu = 0;
    hipGetDevice(&dev);
    hipDeviceGetAttribute(&cus, hipDeviceAttributeMultiprocessorCount, dev);
    hipOccupancyMaxActiveBlocksPerMultiprocessor(&per_cu, fwd_megakernel, 256, 0);
    if (per_cu > 2) per_cu = 2;
    grid_blocks = cus * per_cu;
    if (grid_blocks <= 0 || (grid_blocks & 7)) grid_blocks = -1;
  }
  if (grid_blocks < 0 || ws_size < WS_END || n_in < 16) return;
  Params p{};
  p.x = (const float*)d_in[0]; p.c = (const float*)d_in[1]; p.ctx = (const float*)d_in[2]; p.c_ctx = (const float*)d_in[3];
  p.ada_w = (const float*)d_in[4]; p.ada_b = (const float*)d_in[5]; p.ln_g = (const float*)d_in[6]; p.ln_b = (const float*)d_in[7];
  p.w_out = (const float*)d_in[8]; p.gla_w_in = (const float*)d_in[9]; p.gla_dec_w1 = (const float*)d_in[10]; p.gla_dec_w2 = (const float*)d_in[11];
  p.gla_dec_b = (const float*)d_in[12]; p.gla_norm_g = (const float*)d_in[13]; p.na_w_in = (const float*)d_in[14]; p.na_rpb = (const float*)d_in[15];
  p.out = (float*)d_out; p.ws = (unsigned char*)d_ws;
#if MULTI_LAUNCH
  for (int ph = 0; ph < NPHASES; ++ph) {
    p.ph_lo = ph; p.ph_hi = ph + 1;
    hipLaunchKernelGGL(fwd_megakernel, dim3(grid_blocks), dim3(256), 0, stream, p);
  }
#else
  p.ph_lo = 0; p.ph_hi = NPHASES;
  hipMemsetAsync((char*)d_ws + OFF_BAR, 0, 3456 * 4, stream);
  void* args[] = {&p};
  hipLaunchCooperativeKernel((void*)fwd_megakernel, dim3(grid_blocks), dim3(256), args, 0, stream);
#endif
}
```

```cpp
#include <hip/hip_runtime.h>
#include <hip/hip_cooperative_groups.h>
namespace cg = cooperative_groups;

#define REP_GIN 1
#define REP_GOUT 1
#define REP_PREP 1
#define REP_CHAIN 1
#define REP_NA 1
#ifndef MULTI_LAUNCH
#define MULTI_LAUNCH 0
#endif

#define DI __device__ __forceinline__
typedef short bf16x8 __attribute__((ext_vector_type(8)));
typedef float f32x4 __attribute__((ext_vector_type(4)));
typedef float f32x2 __attribute__((ext_vector_type(2)));
typedef unsigned u32x4 __attribute__((ext_vector_type(4)));
typedef unsigned u32x2 __attribute__((ext_vector_type(2)));
typedef __bf16 bf2 __attribute__((ext_vector_type(2)));
typedef unsigned short u16;

DI unsigned pk2(float lo, float hi) { f32x2 v = {lo, hi}; bf2 b = __builtin_convertvector(v, bf2); return __builtin_bit_cast(unsigned, b); }
DI float bf_lo(unsigned u) { return __uint_as_float(u << 16); }
DI float bf_hi(unsigned u) { return __uint_as_float(u & 0xffff0000u); }
DI float bf2f(u16 h) { return __uint_as_float(((unsigned)h) << 16); }
DI u16 f2bf(float f) { return (u16)(pk2(f, 0.f) & 0xffffu); }
DI f32x4 mfma16(bf16x8 a, bf16x8 b, f32x4 c) { return __builtin_amdgcn_mfma_f32_16x16x32_bf16(a, b, c, 0, 0, 0); }
DI float siluf(float x) { return x * __builtin_amdgcn_rcpf(1.f + __expf(-x)); }

constexpr int D = 1024, NB = 8, SEQ = 2048, CTXL = 256, LSEQ = 2304, MROWS = NB * LSEQ;
constexpr int NCHUNK = 36;
constexpr size_t MiB = 1u << 20;
constexpr size_t U = 36 * MiB;
constexpr size_t OFF_R0 = 0, OFF_R1 = U, OFF_R2 = 2 * U, OFF_R3 = 3 * U, OFF_R4 = 4 * U, OFF_R5 = 5 * U, OFF_R6 = 6 * U;
constexpr size_t OFF_XCTX = 234 * MiB, OFF_WIN = 242 * MiB, OFF_WOUT = 250 * MiB, OFF_LOW = 252 * MiB;
constexpr size_t OFF_DEC = OFF_LOW + (size_t)MROWS * 32 * 2;
constexpr size_t OFF_MOD = OFF_DEC + (size_t)2304 * 128 * 4;
constexpr size_t OFF_ROPE = OFF_MOD + (size_t)4 * 9 * 3072 * 4;
constexpr size_t OFF_BAR = OFF_ROPE + (size_t)2 * 64 * 32 * 4;
constexpr size_t WS_END = OFF_BAR + 3456 * 4;
constexpr float ALPHA = 1.681792830507429f;

struct Ctx { int tid, bid, nblk; };
struct Params {
  const float *x, *c, *ctx, *c_ctx, *ada_w, *ada_b, *ln_g, *ln_b, *w_out, *gla_w_in, *gla_dec_w1, *gla_dec_w2, *gla_dec_b, *gla_norm_g, *na_w_in, *na_rpb;
  float* out; unsigned char* ws; int ph_lo, ph_hi;
};

DI void transpose_tile(const Ctx& cx, const float* __restrict__ src, int N, u16* __restrict__ dst, int k0, int n0, char* smem) {
  float* t = (float*)smem;
  const int tid = cx.tid;
  __syncthreads();
#pragma unroll
  for (int i = 0; i < 4; ++i) {
    int k = (tid >> 4) + 16 * i, n4 = (tid & 15) * 4;
    f32x4 v = *(const f32x4*)(src + (size_t)(k0 + k) * N + n0 + n4);
    t[k * 65 + n4] = v[0]; t[k * 65 + n4 + 1] = v[1]; t[k * 65 + n4 + 2] = v[2]; t[k * 65 + n4 + 3] = v[3];
  }
  __syncthreads();
#pragma unroll
  for (int j = 0; j < 2; ++j) {
    int c = tid + 256 * j, n = c >> 3, kc = (c & 7) * 8;
    u32x4 o;
    o[0] = pk2(t[(kc + 0) * 65 + n], t[(kc + 1) * 65 + n]); o[1] = pk2(t[(kc + 2) * 65 + n], t[(kc + 3) * 65 + n]);
    o[2] = pk2(t[(kc + 4) * 65 + n], t[(kc + 5) * 65 + n]); o[3] = pk2(t[(kc + 6) * 65 + n], t[(kc + 7) * 65 + n]);
    *(u32x4*)(dst + (size_t)(n0 + n) * 1024 + k0 + kc) = o;
  }
}

DI int convert_items(int layer) { return (layer & 1) ? (16 * 64 + 256) : (16 * 48 + 16 + 256); }
DI void convert_item(const Ctx& cx, const Params& p, int layer, int it, char* smem) {
  u16* win = (u16*)(p.ws + OFF_WIN); u16* wout = (u16*)(p.ws + OFF_WOUT);
  const int j = layer >> 1;
  if (layer & 1) {
    if (it < 1024) { transpose_tile(cx, p.na_w_in + (size_t)j * 1024 * 4096, 4096, win, (it >> 6) * 64, (it & 63) * 64, smem); return; }
    it -= 1024;
  } else {
    if (it < 768) { transpose_tile(cx, p.gla_w_in + (size_t)j * 1024 * 3072, 3072, win, (it / 48) * 64, (it % 48) * 64, smem); return; }
    it -= 768;
    if (it < 16) {
      const float* w1 = p.gla_dec_w1 + (size_t)j * 2 * 1024 * 16;
#pragma unroll 4
      for (int idx = cx.tid; idx < 8 * 1024; idx += 256) {
        int row = it * 8 + (idx >> 10), k = idx & 1023;
        float v = row < 32 ? w1[((size_t)(row >> 4) * 1024 + k) * 16 + (row & 15)] : 0.f;
        win[(size_t)(3072 + row) * 1024 + k] = f2bf(v);
      }
      return;
    }
    it -= 16;
  }
  transpose_tile(cx, p.w_out + (size_t)layer * 1024 * 1024, 1024, wout, (it >> 4) * 64, (it & 15) * 64, smem);
}

DI void phase0a(const Ctx& cx, const Params& p, char* smem) {
  const int tid = cx.tid;
  float* mod = (float*)(p.ws + OFF_MOD);
  const int nconv = convert_items(0);
  const int nitems = 384 + nconv + 1;
  bool sc_ready = false;
  float* sc = (float*)smem;
  float* red = (float*)(smem + 36864);
  for (int it = cx.bid; it < nitems; it += cx.nblk) {
    if (it < 384) {
      if (!sc_ready) {
        {
          float cv[36];
#pragma unroll
          for (int u = 0; u < 32; ++u) cv[u] = p.c[tid + 256 * u];
#pragma unroll
          for (int u = 0; u < 4; ++u) cv[32 + u] = p.c_ctx[tid + 256 * u];
#pragma unroll
          for (int u = 0; u < 36; ++u) sc[tid + 256 * u] = siluf(cv[u]);
        }
        sc_ready = true;
      }
      __syncthreads();
      const int layer = it / 96, col0 = (it % 96) * 32;
      const int c4 = tid & 7, kg = tid >> 3;
      const float* W = p.ada_w + (size_t)layer * 1024 * 3072 + col0 + c4 * 4;
      f32x4 acc[9];
#pragma unroll
      for (int c = 0; c < 9; ++c) acc[c] = (f32x4){0.f, 0.f, 0.f, 0.f};
      for (int i0 = 0; i0 < 32; i0 += 8) {
        f32x4 wv[8];
#pragma unroll
        for (int u = 0; u < 8; ++u) wv[u] = *(const f32x4*)(W + (size_t)(kg + 32 * (i0 + u)) * 3072);
#pragma unroll
        for (int u = 0; u < 8; ++u) {
          const int k = kg + 32 * (i0 + u);
#pragma unroll
          for (int c = 0; c < 9; ++c) { float s2 = sc[c * 1024 + k]; acc[c] += wv[u] * s2; }
        }
      }
#pragma unroll
      for (int c = 0; c < 9; ++c)
#pragma unroll
        for (int e = 0; e < 4; ++e) { float v = acc[c][e]; v += __shfl_xor(v, 8); v += __shfl_xor(v, 16); v += __shfl_xor(v, 32); acc[c][e] = v; }
      const int w = tid >> 6, lane = tid & 63;
      if (lane < 8) {
#pragma unroll
        for (int c = 0; c < 9; ++c)
#pragma unroll
          for (int e = 0; e < 4; ++e) red[(w * 9 + c) * 32 + lane * 4 + e] = acc[c][e];
      }
      __syncthreads();
      for (int o = tid; o < 9 * 32; o += 256) {
        int c = o >> 5, col = o & 31;
        float v = red[(0 * 9 + c) * 32 + col] + red[(1 * 9 + c) * 32 + col] + red[(2 * 9 + c) * 32 + col] + red[(3 * 9 + c) * 32 + col];
        v += p.ada_b[layer * 3072 + col0 + col];
        mod[((size_t)layer * 9 + c) * 3072 + col0 + col] = v;
      }
      __syncthreads();
    } else if (it < 384 + nconv) {
      __syncthreads();
      sc_ready = false;
      convert_item(cx, p, 0, it - 384, smem);
    } else {
      float* rc = (float*)(p.ws + OFF_ROPE); float* rs = rc + 2048;
      for (int i = tid; i < 2048; i += 256) {
        int pos = i >> 5, q = i & 31;
        float inv = __builtin_amdgcn_exp2f(-(float)q * (13.287712379549449f / 32.f));
        float rev = (float)pos * inv * 0.15915494309189535f;
        rc[i] = __builtin_amdgcn_cosf(rev); rs[i] = __builtin_amdgcn_sinf(rev);
      }
    }
  }
}

DI const float* resid_in(const Params& p, int layer, int b, int pos) {
  if (pos < CTXL) return (layer == 0 ? p.ctx : (const float*)(p.ws + OFF_XCTX)) + ((size_t)b * CTXL + pos) * D;
  return (layer == 0 ? p.x : (const float*)p.out) + ((size_t)b * SEQ + (pos - CTXL)) * D;
}
DI float* resid_out(const Params& p, int b, int pos) {
  if (pos < CTXL) return (float*)(p.ws + OFF_XCTX) + ((size_t)b * CTXL + pos) * D;
  return p.out + ((size_t)b * SEQ + (pos - CTXL)) * D;
}

DI void phase0b(const Ctx& cx, const Params& p) {
  const int lane = cx.tid & 63, wg = (cx.bid * 256 + cx.tid) >> 6, nw = cx.nblk * 4;
  const float* mod = (const float*)(p.ws + OFF_MOD);
  u16* H = (u16*)(p.ws + OFF_R0);
  for (int m0 = wg; m0 < MROWS; m0 += 2 * nw) {
    f32x4 xv[2][4], sh[2][4], sc[2][4];
#pragma unroll
    for (int q = 0; q < 2; ++q) {
      const int m = m0 + q * nw;
      if (m < MROWS) {
        const int b = m / LSEQ, pos = m % LSEQ;
        const float* xr = resid_in(p, 0, b, pos);
        const float* md = mod + (size_t)(0 * 9 + (pos < CTXL ? 8 : b)) * 3072;
#pragma unroll
        for (int i = 0; i < 4; ++i) { const int c = 4 * lane + 256 * i; xv[q][i] = *(const f32x4*)(xr + c); sh[q][i] = *(const f32x4*)(md + c); sc[q][i] = *(const f32x4*)(md + 1024 + c); }
      }
    }
#pragma unroll
    for (int q = 0; q < 2; ++q) {
      const int m = m0 + q * nw;
      if (m >= MROWS) continue;
#pragma unroll
      for (int i = 0; i < 4; ++i) {
        const int c = 4 * lane + 256 * i;
        f32x4 h = xv[q][i] * (sc[q][i] + 1.f) + sh[q][i];
        u32x2 o = {pk2(h[0], h[1]), pk2(h[2], h[3])};
        *(u32x2*)(H + (size_t)m * D + c) = o;
      }
    }
  }
}

DI void gemm_tile(const Ctx& cx, const u16* __restrict__ A, const u16* __restrict__ Bt, int row0, int col0, char* smem, f32x4 (&acc)[4][8]) {
  const int tid = cx.tid, lane = tid & 63, w = tid >> 6, wm = w >> 1, wn = w & 1, l15 = lane & 15, g = lane >> 4;
  const char* Abase = (const char*)(A + (size_t)row0 * 1024);
  const char* Bbase = (const char*)(Bt + (size_t)col0 * 1024);
  unsigned voA[4], voB[2];
#pragma unroll
  for (int i = 0; i < 4; ++i) { const int row = w * 64 + i * 16 + (lane >> 2), ch = (lane & 3) ^ ((-(row >> 2)) & 3); voA[i] = (unsigned)(row * 2048 + ch * 16); }
#pragma unroll
  for (int i = 0; i < 2; ++i) {
    const int row = w * 32 + i * 16 + (lane >> 2), ch = (lane & 3) ^ ((-(row >> 2)) & 3);
    const int r32 = row & 31, grow = (row & ~31) + 8 * ((r32 & 15) >> 2) + 4 * (r32 >> 4) + (r32 & 3);
    voB[i] = (unsigned)(grow * 2048 + ch * 16); }
  const int lA = w * 4096 + lane * 16, lB = 16384 + w * 2048 + lane * 16;
  const unsigned fo = (unsigned)(size_t)smem + l15 * 64 + ((g ^ ((-(l15 >> 2)) & 3)) << 4);
  const unsigned xbase = fo + 16384 + wn * 4096, ybase = fo + wm * 8192;
#pragma unroll
  for (int i = 0; i < 4; ++i)
#pragma unroll
    for (int j = 0; j < 8; ++j) acc[i][j] = (f32x4){0.f, 0.f, 0.f, 0.f};
#define GL_STAGE(kt_, so_) do { const char* ak_ = Abase + (kt_) * 64; const char* bk_ = Bbase + (kt_) * 64; char* sb_ = smem + (so_); \
    _Pragma("unroll") for (int i = 0; i < 4; ++i) { asm volatile("" : "+v"(voA[i]));   \
      __builtin_amdgcn_global_load_lds((const unsigned*)(ak_ + voA[i]), (unsigned*)(sb_ + lA + i * 1024), 16, 0, 0); } \
    _Pragma("unroll") for (int i = 0; i < 2; ++i) { asm volatile("" : "+v"(voB[i])); \
      __builtin_amdgcn_global_load_lds((const unsigned*)(bk_ + voB[i]), (unsigned*)(sb_ + lB + i * 1024), 16, 0, 0); } } while (0)
#define GL_STAGE_A(kt_, so_) do { const char* ak_ = Abase + (kt_) * 64; char* sb_ = smem + (so_); \
    _Pragma("unroll") for (int i = 0; i < 4; ++i) { asm volatile("" : "+v"(voA[i])); \
      __builtin_amdgcn_global_load_lds((const unsigned*)(ak_ + voA[i]), (unsigned*)(sb_ + lA + i * 1024), 16, 0, 0); } } while (0)
#define GL_STAGE_B(kt_, so_) do { const char* bk_ = Bbase + (kt_) * 64; char* sb_ = smem + (so_); \
    _Pragma("unroll") for (int i = 0; i < 2; ++i) { asm volatile("" : "+v"(voB[i])); \
      __builtin_amdgcn_global_load_lds((const unsigned*)(bk_ + voB[i]), (unsigned*)(sb_ + lB + i * 1024), 16, 0, 0); } } while (0)
#define DS_RD(dst, addr, off) asm volatile("ds_read_b128 %0, %1 offset:%2" : "=v"(dst) : "v"(addr), "n"(off))
  GL_STAGE(0, 0); GL_STAGE(1, 24576);
  if (cx.bid & 256) __builtin_amdgcn_s_sleep(4);
  int sc = 0;
  for (int kt = 0; kt < 32; ++kt) {
    if (kt < 31) asm volatile("s_waitcnt vmcnt(6)" ::: "memory");
    else asm volatile("s_waitcnt vmcnt(0)" ::: "memory");
    __builtin_amdgcn_s_barrier();
    const int sn = sc == 0 ? 49152 : sc - 24576;
    const unsigned xa = xbase + sc, ya = ybase + sc;
    bf16x8 xf[4], yf[8];
    DS_RD(xf[0], xa, 0); DS_RD(xf[1], xa, 1024); DS_RD(xf[2], xa, 2048); DS_RD(xf[3], xa, 3072);
    DS_RD(yf[0], ya, 0); DS_RD(yf[1], ya, 1024); DS_RD(yf[2], ya, 2048); DS_RD(yf[3], ya, 3072);
    DS_RD(yf[4], ya, 4096); DS_RD(yf[5], ya, 5120); DS_RD(yf[6], ya, 6144); DS_RD(yf[7], ya, 7168);
    if (kt + 2 < 32) GL_STAGE_A(kt + 2, sn);
    asm volatile("s_waitcnt lgkmcnt(4)" : "+v"(xf[0]), "+v"(xf[1]), "+v"(xf[2]), "+v"(xf[3]), "+v"(yf[0]), "+v"(yf[1]), "+v"(yf[2]), "+v"(yf[3]) :: "memory");
    __builtin_amdgcn_sched_barrier(0);
#pragma unroll
    for (int i = 0; i < 4; ++i)
#pragma unroll
      for (int j = 0; j < 4; ++j) acc[i][j] = mfma16(xf[i], yf[j], acc[i][j]);
    __builtin_amdgcn_sched_barrier(0);
    if (kt + 2 < 32) GL_STAGE_B(kt + 2, sn);
    asm volatile("s_waitcnt lgkmcnt(0)" : "+v"(yf[4]), "+v"(yf[5]), "+v"(yf[6]), "+v"(yf[7]) :: "memory");
    __builtin_amdgcn_sched_barrier(0);
#pragma unroll
    for (int i = 0; i < 4; ++i)
#pragma unroll
      for (int j = 4; j < 8; ++j) acc[i][j] = mfma16(xf[i], yf[j], acc[i][j]);
    __builtin_amdgcn_sched_barrier(0);
    sc = sc == 49152 ? 0 : sc + 24576;
  }
#undef GL_STAGE
#undef GL_STAGE_A
#undef GL_STAGE_B
#undef DS_RD
  __builtin_amdgcn_s_barrier();
}

DI void store_T(const Ctx& cx, const f32x4 (&acc)[4][8], u16* dst, int ld, int row0, int fcol0, float scale, char* smem) {
  const int lane = cx.tid & 63, w = cx.tid >> 6, wm = w >> 1, wn = w & 1, l15 = lane & 15, g = lane >> 4;
  char* img = smem + w * 18432;
#pragma unroll
  for (int yj = 0; yj < 8; ++yj)
#pragma unroll
    for (int xp = 0; xp < 2; ++xp) {
      f32x4 v0 = acc[2 * xp][yj] * scale, v1 = acc[2 * xp + 1][yj] * scale;
      u32x4 o = {pk2(v0[0], v0[1]), pk2(v0[2], v0[3]), pk2(v1[0], v1[1]), pk2(v1[2], v1[3])};
      *(u32x4*)(img + (yj * 16 + l15) * 144 + xp * 64 + 16 * g) = o;
    }
  __builtin_amdgcn_fence(__ATOMIC_RELEASE, "wavefront");
  asm volatile("s_waitcnt lgkmcnt(0)" ::: "memory");
  char* base = (char*)(dst + (size_t)(row0 + wm * 128) * ld + fcol0 + wn * 64) + (lane & 7) * 16;
  const int tr = lane >> 3;
#pragma unroll
  for (int k = 0; k < 16; ++k) {
    const int t = 8 * k + tr;
    u32x4 v = *(const u32x4*)(img + t * 144 + (lane & 7) * 16);
    *(u32x4*)(base + (size_t)((unsigned)(t * ld) * 2u)) = v;
  }
  __syncthreads();
}
DI void store_VT(const Ctx& cx, const f32x4 (&acc)[4][8], u16* vt, int b, int pos0, int fcol0, char* smem) {
  const int tid = cx.tid, lane = tid & 63, w = tid >> 6, wm = w >> 1, wn = w & 1, l15 = lane & 15, g = lane >> 4;
#pragma unroll
  for (int xi = 0; xi < 4; ++xi)
#pragma unroll
    for (int yj = 0; yj < 8; ++yj) {
      const unsigned p01 = pk2(acc[xi][yj][0], acc[xi][yj][1]), p23 = pk2(acc[xi][yj][2], acc[xi][yj][3]);
      const int f = wn * 64 + (xi >> 1) * 32 + 8 * g + 4 * (xi & 1), t = wm * 128 + yj * 16 + l15;
      char* d = smem + f * 528 + t * 2;
      *(u16*)(d) = (u16)(p01 & 0xffffu); *(u16*)(d + 528) = (u16)(p01 >> 16);
      *(u16*)(d + 1056) = (u16)(p23 & 0xffffu); *(u16*)(d + 1584) = (u16)(p23 >> 16);
    }
  __syncthreads();
#pragma unroll
  for (int i = 0; i < 16; ++i) {
    const int c = tid + 256 * i, f = c >> 5, tc = c & 31;
    u32x4 v = *(const u32x4*)(smem + f * 528 + tc * 16);
    *(u32x4*)(vt + (size_t)((unsigned)((b * 1024 + fcol0 + f) * LSEQ + pos0 + tc * 8))) = v;
  }
  __syncthreads();
}

DI void gemm_phase(const Ctx& cx, const Params& p, int kind, int layer, char* smem) {
  const int NC = kind == 0 ? 25 : (kind == 1 ? 32 : 8);
  const u16* A = (const u16*)(p.ws + OFF_R0);
  const u16* Bt = (const u16*)(p.ws + (kind == 2 ? OFF_WOUT : OFF_WIN));
  const bool last = (layer == 3);
  const int nitems = 72 * NC;
  for (int it = cx.bid; it < nitems; it += cx.nblk) {
    const int xcd = it & 7, j = it >> 3;
    const int grp = j / 72, rem = j - grp * 72, gw = min(8, NC - grp * 8);
    const int rt = (rem / gw) * 8 + xcd, ct = grp * 8 + rem % gw;
    const int b = rt / 9, pos0 = (rt % 9) * 256, row0 = rt * 256, col0 = ct * 128;
    const bool isctx = pos0 < CTXL;
    if (kind == 1) { if (last && isctx && (ct < 8 || ct >= 24)) continue; }
    else if (kind == 2) { if (last && isctx) continue; }
    f32x4 acc[4][8];
    gemm_tile(cx, A, Bt, row0, col0, smem, acc);
    Ctx cx2 = cx; asm volatile("" : "+v"(cx2.tid));
    if (kind == 0) {
      if (ct < 8) store_T(cx2, acc, (u16*)(p.ws + OFF_R1), 1024, row0, col0, ct < 4 ? 0.08838834764831845f : 1.f, smem);
      else if (ct < 16) store_VT(cx2, acc, (u16*)(p.ws + OFF_R3), b, pos0, col0 - 1024, smem);
      else if (ct < 24) store_T(cx2, acc, (u16*)(p.ws + OFF_R4), 1024, row0, col0 - 2048, 1.f, smem);
      else {
        const int lane = cx2.tid & 63, w = cx2.tid >> 6, wm = w >> 1, wn = w & 1, l15 = lane & 15, g = lane >> 4;
        u16* low = (u16*)(p.ws + OFF_LOW);
        if (wn == 0) {
#pragma unroll
          for (int yj = 0; yj < 8; ++yj) {
            const unsigned token = row0 + wm * 128 + yj * 16 + l15;
            f32x4 v0 = acc[0][yj], v1 = acc[1][yj];
            u32x4 o = {pk2(v0[0], v0[1]), pk2(v0[2], v0[3]), pk2(v1[0], v1[1]), pk2(v1[2], v1[3])};
            *(u32x4*)(low + (size_t)(token * 32u + 8 * g)) = o;
          }
        }
      }
    } else if (kind == 1) {
      if (ct < 8) store_T(cx2, acc, (u16*)(p.ws + OFF_R1), 1024, row0, col0, 0.125f * 1.4426950408889634f, smem);
      else if (ct < 16) store_T(cx2, acc, (u16*)(p.ws + OFF_R2), 1024, row0, col0 - 1024, 1.f, smem);
      else if (ct < 24) store_VT(cx2, acc, (u16*)(p.ws + OFF_R3), b, pos0, col0 - 2048, smem);
      else store_T(cx2, acc, (u16*)(p.ws + OFF_R4), 1024, row0, col0 - 3072, 1.f, smem);
    } else {
      store_T(cx2, acc, (u16*)(p.ws + OFF_R2), 1024, row0, col0, 1.f, smem);
    }
  }
}

DI void gla_prep_phase(const Ctx& cx, const Params& p, int layer, char* smem) {
  const int tid = cx.tid, lane = tid & 63, w = tid >> 6, l15 = lane & 15, g = lane >> 4;
  const int jl = layer >> 1;
  char* qS = smem; char* kS = smem + 16384;
  float* lowS = (float*)(smem + 32768);
  float* totS = (float*)(smem + 32768 + 4096);
  const u16* QK = (const u16*)(p.ws + OFF_R1);
  const u16* LOW = (const u16*)(p.ws + OFF_LOW);
  u16* QT = (u16*)(p.ws + OFF_R2); u16* KE = (u16*)(p.ws + OFF_R5); u16* ATT = (u16*)(p.ws + OFF_R6);
  float* DEC = (float*)(p.ws + OFF_DEC);
  const float* ropeC = (const float*)(p.ws + OFF_ROPE); const float* ropeS = ropeC + 2048;
  const int d6 = tid & 63, tq = tid >> 6;
  float* ropeL = (float*)(smem + 40960);
  {
    u32x4 rv[4];
#pragma unroll
    for (int u = 0; u < 4; ++u) rv[u] = *(const u32x4*)(ropeC + (tid + 256 * u) * 4);
#pragma unroll
    for (int u = 0; u < 4; ++u) *(u32x4*)(ropeL + (tid + 256 * u) * 4) = rv[u];
  }
  for (int it = cx.bid; it < NB * NCHUNK * 8; it += cx.nblk) {
    const int dir = it & 1, h = (it >> 1) & 3, bn = it >> 3, n = bn % NCHUNK, b = bn / NCHUNK;
    const size_t m0 = (size_t)b * LSEQ + n * 64;
    __syncthreads();
#pragma unroll
    for (int i = 0; i < 4; ++i) {
      int c = tid + 256 * i, row = c >> 4, ch = c & 15;
      u32x4 vq = *(const u32x4*)(QK + (m0 + row) * 1024 + h * 128 + ch * 8);
      u32x4 vk = *(const u32x4*)(QK + (m0 + row) * 1024 + 512 + h * 128 + ch * 8);
      int o = row * 256 + ((ch ^ (row & 15)) << 4);
      *(u32x4*)(qS + o) = vq; *(u32x4*)(kS + o) = vk;
    }
#pragma unroll
    for (int i = 0; i < 4; ++i) {
      int idx = tid + 256 * i, t = idx >> 4, r = idx & 15;
      lowS[idx] = bf2f(LOW[(m0 + t) * 32 + dir * 16 + r]);
    }
    float w2a[16], w2b[16];
    const float* w2 = p.gla_dec_w2 + ((size_t)(jl * 2 + dir) * 16) * 512 + h * 128 + d6;
#pragma unroll
    for (int r = 0; r < 16; ++r) { w2a[r] = w2[r * 512]; w2b[r] = w2[r * 512 + 64]; }
    const float ba = p.gla_dec_b[(jl * 2 + dir) * 512 + h * 128 + d6], bb = p.gla_dec_b[(jl * 2 + dir) * 512 + h * 128 + d6 + 64];
    __syncthreads();
    float la0[16], la1[16];
    float s0 = 0.f, s1 = 0.f;
#pragma unroll
    for (int tt = 0; tt < 16; ++tt) {
      const int t = tq * 16 + tt;
      float x0 = ba, x1 = bb;
#pragma unroll
      for (int r4 = 0; r4 < 4; ++r4) {
        f32x4 lv = *(const f32x4*)(lowS + t * 16 + r4 * 4);
#pragma unroll
        for (int e = 0; e < 4; ++e) { x0 += lv[e] * w2a[r4 * 4 + e]; x1 += lv[e] * w2b[r4 * 4 + e]; }
      }
      float l0 = (fminf(x0, 0.f) - __logf(1.f + __expf(-fabsf(x0)))) * 0.0625f;
      float l1 = (fminf(x1, 0.f) - __logf(1.f + __expf(-fabsf(x1)))) * 0.0625f;
      la0[tt] = l0; la1[tt] = l1; s0 += l0; s1 += l1;
    }
    totS[tq * 128 + d6] = s0; totS[tq * 128 + d6 + 64] = s1;
    __syncthreads();
    float off0 = 0.f, off1 = 0.f, tot0 = 0.f, tot1 = 0.f;
#pragma unroll
    for (int q = 0; q < 4; ++q) {
      float a = totS[q * 128 + d6], bq = totS[q * 128 + d6 + 64];
      tot0 += a; tot1 += bq;
      bool inc = dir == 0 ? (q < tq) : (q > tq);
      if (inc) { off0 += a; off1 += bq; }
    }
    const float dec0 = __expf(tot0), dec1 = __expf(tot1);
    if (tq == 0) { DEC[(size_t)it * 128 + d6] = dec0; DEC[(size_t)it * 128 + d6 + 64] = dec1; }
    const bool do_rope = n >= 4;
    unsigned ke0[8], ke1[8];
    float run0 = 0.f, run1 = 0.f, keprev0 = 0.f, keprev1 = 0.f;
#pragma unroll
    for (int hb = 0; hb < 2; ++hb) {
      unsigned qv[8], kv[8]; float csv[8], snv[8];
#pragma unroll
      for (int t8 = 0; t8 < 8; ++t8) {
        const int tt = hb * 8 + t8, t = tq * 16 + tt;
        const int o0 = t * 256 + (((d6 >> 3) ^ tt) << 4) + (d6 & 7) * 2;
        const int o1 = t * 256 + ((((d6 >> 3) + 8) ^ tt) << 4) + (d6 & 7) * 2;
        qv[t8] = (unsigned)*(const u16*)(qS + o0) | ((unsigned)*(const u16*)(qS + o1) << 16);
        kv[t8] = (unsigned)*(const u16*)(kS + o0) | ((unsigned)*(const u16*)(kS + o1) << 16);
        const int pos = d6 < 32 ? (do_rope ? n - 4 : 0) : t;
        csv[t8] = ropeL[pos * 32 + (d6 & 31)]; snv[t8] = ropeL[2048 + pos * 32 + (d6 & 31)];
      }
      asm volatile("" ::: "memory");
#pragma unroll
      for (int t8 = 0; t8 < 8; ++t8) {
        const int tt = hb * 8 + t8, t = tq * 16 + tt;
        const float rp0 = run0, rp1 = run1;
        run0 += la0[tt]; run1 += la1[tt];
        const float c0 = dir == 0 ? off0 + run0 : off0 + (s0 - rp0), c1 = dir == 0 ? off1 + run1 : off1 + (s1 - rp1);
        const float qb0 = dir == 0 ? c0 : c0 - la0[tt], qb1 = dir == 0 ? c1 : c1 - la1[tt];
        const int o0 = t * 256 + (((d6 >> 3) ^ tt) << 4) + (d6 & 7) * 2;
        const int o1 = t * 256 + ((((d6 >> 3) + 8) ^ tt) << 4) + (d6 & 7) * 2;
        float q0 = bf_lo(qv[t8]), q1 = bf_hi(qv[t8]);
        float k0 = bf_lo(kv[t8]), k1 = bf_hi(kv[t8]);
        if (do_rope) {
          const float cs = csv[t8], sn = snv[t8];
          float a = q0 * cs - q1 * sn, bq = q0 * sn + q1 * cs; q0 = a; q1 = bq;
          a = k0 * cs - k1 * sn; bq = k0 * sn + k1 * cs; k0 = a; k1 = bq;
        }
        const float kt0 = k0 * __expf(-c0), kt1 = k1 * __expf(-c1);
        *(u16*)(qS + o0) = f2bf(q0 * __expf(qb0)); *(u16*)(qS + o1) = f2bf(q1 * __expf(qb1));
        *(u16*)(kS + o0) = f2bf(kt0); *(u16*)(kS + o1) = f2bf(kt1);
        const float e0 = kt0 * dec0, e1 = kt1 * dec1;
        if (tt & 1) { ke0[tt >> 1] = pk2(keprev0, e0); ke1[tt >> 1] = pk2(keprev1, e1); } else { keprev0 = e0; keprev1 = e1; }
      }
      asm volatile("" ::: "memory");
    }
    {
      char* kimg = smem + 57344;
      u32x4 a = {ke0[0], ke0[1], ke0[2], ke0[3]}, bq = {ke0[4], ke0[5], ke0[6], ke0[7]};
      *(u32x4*)(kimg + d6 * 128 + (((tq * 2) ^ (d6 & 7)) << 4)) = a; *(u32x4*)(kimg + d6 * 128 + (((tq * 2 + 1) ^ (d6 & 7)) << 4)) = bq;
      u32x4 c = {ke1[0], ke1[1], ke1[2], ke1[3]}, d = {ke1[4], ke1[5], ke1[6], ke1[7]};
      *(u32x4*)(kimg + (d6 + 64) * 128 + (((tq * 2) ^ (d6 & 7)) << 4)) = c; *(u32x4*)(kimg + (d6 + 64) * 128 + (((tq * 2 + 1) ^ (d6 & 7)) << 4)) = d;
    }
    __syncthreads();
#pragma unroll
    for (int i = 0; i < 4; ++i) {
      const int c = tid + 256 * i, row = c >> 3, ch = c & 7;
      u32x4 v = *(const u32x4*)(smem + 57344 + row * 128 + ((ch ^ (row & 7)) << 4));
      *(u32x4*)(KE + (size_t)it * 8192 + c * 8) = v;
    }
#pragma unroll
    for (int i = 0; i < 4; ++i) {
      int c = tid + 256 * i, row = c >> 4, ch = c & 15;
      u32x4 v = *(const u32x4*)(qS + row * 256 + ((ch ^ (row & 15)) << 4));
      *(u32x4*)(QT + (size_t)it * 8192 + c * 8) = v;
    }
    {
      f32x4 at[4];
#pragma unroll
      for (int st = 0; st < 4; ++st) at[st] = (f32x4){0.f, 0.f, 0.f, 0.f};
#pragma unroll
      for (int kk = 0; kk < 4; ++kk) {
        const int co = ((kk * 4 + g) ^ l15) << 4;
        bf16x8 qf = *(const bf16x8*)(qS + (16 * w + l15) * 256 + co);
#pragma unroll
        for (int st = 0; st < 4; ++st) {
          bf16x8 kf = *(const bf16x8*)(kS + (16 * st + l15) * 256 + co);
          at[st] = mfma16(kf, qf, at[st]);
        }
      }
      const int t = 16 * w + l15;
#pragma unroll
      for (int st = 0; st < 4; ++st) {
        float v[4];
#pragma unroll
        for (int jj = 0; jj < 4; ++jj) { int s = 16 * st + 4 * g + jj; bool keep = dir == 0 ? (s <= t) : (s > t); v[jj] = keep ? at[st][jj] : 0.f; }
        u32x2 o = {pk2(v[0], v[1]), pk2(v[2], v[3])};
        *(u32x2*)(ATT + (size_t)it * 4096 + t * 64 + 16 * st + 4 * g) = o;
      }
    }
  }
}

DI void gla_chain_phase(const Ctx& cx, const Params& p, char* smem) {
  const int tid = cx.tid, lane = tid & 63, w = tid >> 6, l15 = lane & 15, g = lane >> 4;
  char* qtS = smem; char* keS = smem + 16384; char* atS = smem + 32768; char* vtS = smem + 40960; float* decS = (float*)(smem + 49152);
  const u16* QT = (const u16*)(p.ws + OFF_R2); const u16* KE = (const u16*)(p.ws + OFF_R5); const u16* ATT = (const u16*)(p.ws + OFF_R6);
  const u16* VT = (const u16*)(p.ws + OFF_R3); const float* DEC = (const float*)(p.ws + OFF_DEC);
  const int sw7 = (l15 >> 1) & 7;
  for (int it = cx.bid; it < 256; it += cx.nblk) {
    const int sl = it & 3, dir = (it >> 2) & 1, h = (it >> 3) & 3, b = it >> 5;
    u16* O = (u16*)(p.ws + (dir == 0 ? OFF_R1 : OFF_R0));
    f32x4 S[8]; bf16x8 Sbf[4];
#pragma unroll
    for (int a = 0; a < 8; ++a) S[a] = (f32x4){0.f, 0.f, 0.f, 0.f};
#pragma unroll
    for (int kk = 0; kk < 4; ++kk) Sbf[kk] = (bf16x8){0, 0, 0, 0, 0, 0, 0, 0};
    u32x4 pf[12]; f32x4 pfd = {0.f, 0.f, 0.f, 0.f};
    auto chunk_of = [&](int j) { return dir == 0 ? j : (j < 4 ? 3 - j : 39 - j); };
    auto issue = [&](int j) {
      const int n = chunk_of(j);
      const size_t pi = ((size_t)(b * NCHUNK + n) * 4 + h) * 2 + dir;
      const char* qb = (const char*)(QT + pi * 8192); const char* kb = (const char*)(KE + pi * 8192); const char* ab = (const char*)(ATT + pi * 4096);
      const char* vb = (const char*)(VT + ((size_t)b * 1024 + h * 256 + sl * 64) * LSEQ + n * 64);
      const unsigned lo = (unsigned)tid * 16u;
#pragma unroll
      for (int i = 0; i < 4; ++i) pf[i] = *(const u32x4*)(qb + lo + i * 4096);
#pragma unroll
      for (int i = 0; i < 4; ++i) pf[4 + i] = *(const u32x4*)(kb + lo + i * 4096);
#pragma unroll
      for (int i = 0; i < 2; ++i) pf[8 + i] = *(const u32x4*)(ab + lo + i * 4096);
#pragma unroll
      for (int i = 0; i < 2; ++i) { const unsigned c = tid + 256 * i, row = c >> 3, ch = c & 7; pf[10 + i] = *(const u32x4*)(vb + (row * LSEQ + ch * 8) * 2u); }
      if (tid < 32) pfd = *(const f32x4*)(DEC + pi * 128 + tid * 4);
    };
    auto commit = [&]() {
#pragma unroll
      for (int i = 0; i < 4; ++i) { int c = tid + 256 * i, row = c >> 4, ch = c & 15; *(u32x4*)(qtS + row * 256 + ((ch ^ (row & 15)) << 4)) = pf[i]; }
#pragma unroll
      for (int i = 0; i < 4; ++i) { int c = tid + 256 * i, row = c >> 3, ch = c & 7; *(u32x4*)(keS + row * 128 + ((ch ^ ((row >> 1) & 7)) << 4)) = pf[4 + i]; }
#pragma unroll
      for (int i = 0; i < 2; ++i) { int c = tid + 256 * i, row = c >> 3, ch = c & 7; *(u32x4*)(atS + row * 128 + ((ch ^ ((row >> 1) & 7)) << 4)) = pf[8 + i]; }
#pragma unroll
      for (int i = 0; i < 2; ++i) { int c = tid + 256 * i, row = c >> 3, ch = c & 7; *(u32x4*)(vtS + row * 128 + ((ch ^ ((row >> 1) & 7)) << 4)) = pf[10 + i]; }
      if (tid < 32) *(f32x4*)(decS + tid * 4) = pfd;
    };
    __syncthreads();
    issue(0); commit();
    __syncthreads();
    for (int j = 0; j < NCHUNK; ++j) {
      const int n = chunk_of(j);
      if (j + 1 < NCHUNK) issue(j + 1);
#define SB __builtin_amdgcn_sched_barrier(0)
#define LOADQ(QF, KK0) do { _Pragma("unroll") for (int k2 = 0; k2 < 2; ++k2) _Pragma("unroll") for (int tt = 0; tt < 4; ++tt) { \
        const int row = 16 * tt + l15; const int e0 = 32 * ((KK0) + k2) + 4 * g, e1 = e0 + 16; \
        u32x2 lo = *(const u32x2*)(qtS + row * 256 + (((e0 >> 3) ^ l15) << 4) + (e0 & 7) * 2); \
        u32x2 hi = *(const u32x2*)(qtS + row * 256 + (((e1 >> 3) ^ l15) << 4) + (e1 & 7) * 2); \
        u32x4 q4 = {lo[0], lo[1], hi[0], hi[1]}; QF[k2][tt] = __builtin_bit_cast(bf16x8, q4); } } while (0)
      bf16x8 vf[2], af[4][2];
#pragma unroll
      for (int kk = 0; kk < 2; ++kk) vf[kk] = *(const bf16x8*)(vtS + (16 * w + l15) * 128 + (((kk * 4 + g) ^ sw7) << 4));
#pragma unroll
      for (int tt = 0; tt < 4; ++tt)
#pragma unroll
        for (int kk = 0; kk < 2; ++kk) af[tt][kk] = *(const bf16x8*)(atS + (16 * tt + l15) * 128 + (((kk * 4 + g) ^ sw7) << 4));
      bf16x8 qa[2][4];
      LOADQ(qa, 0);
      SB;
      f32x4 o[4];
#pragma unroll
      for (int tt = 0; tt < 4; ++tt) {
        o[tt] = mfma16(vf[0], af[tt][0], (f32x4){0.f, 0.f, 0.f, 0.f});
        o[tt] = mfma16(vf[1], af[tt][1], o[tt]);
      }
      SB;
      bf16x8 qb[2][4];
      LOADQ(qb, 2);
      SB;
#pragma unroll
      for (int k2 = 0; k2 < 2; ++k2)
#pragma unroll
        for (int tt = 0; tt < 4; ++tt) o[tt] = mfma16(Sbf[k2], qa[k2][tt], o[tt]);
      SB;
#define LOADK(KF, DF, A0) do { _Pragma("unroll") for (int a = 0; a < 2; ++a) { DF[a] = *(const f32x4*)(decS + 16 * ((A0) + a) + 4 * g); \
        _Pragma("unroll") for (int kk = 0; kk < 2; ++kk) KF[a][kk] = *(const bf16x8*)(keS + (16 * ((A0) + a) + l15) * 128 + (((kk * 4 + g) ^ sw7) << 4)); } } while (0)
#define SUPD(KF, DF, A0) do { _Pragma("unroll") for (int a = 0; a < 2; ++a) { S[(A0) + a] *= DF[a]; \
        S[(A0) + a] = mfma16(KF[a][0], vf[0], S[(A0) + a]); S[(A0) + a] = mfma16(KF[a][1], vf[1], S[(A0) + a]); } } while (0)
      bf16x8 k0[2][2], k1[2][2]; f32x4 d0[2], d1[2];
      LOADK(k0, d0, 0);
      SB;
#pragma unroll
      for (int k2 = 0; k2 < 2; ++k2)
#pragma unroll
        for (int tt = 0; tt < 4; ++tt) o[tt] = mfma16(Sbf[2 + k2], qb[k2][tt], o[tt]);
      SB;
      LOADK(k1, d1, 2);
      SB;
      SUPD(k0, d0, 0);
      SB;
#pragma unroll
      for (int tt = 0; tt < 4; ++tt) {
        size_t m = (size_t)b * LSEQ + n * 64 + 16 * tt + l15;
        u32x2 ov = {pk2(o[tt][0], o[tt][1]), pk2(o[tt][2], o[tt][3])};
        *(u32x2*)(O + m * 1024 + h * 256 + sl * 64 + 16 * w + 4 * g) = ov;
      }
      LOADK(k0, d0, 4);
      SB;
      SUPD(k1, d1, 2);
      SB;
      LOADK(k1, d1, 6);
      SB;
      SUPD(k0, d0, 4);
      SB;
      SUPD(k1, d1, 6);
#undef LOADK
#undef SUPD
#undef SB
#undef LOADQ
#pragma unroll
      for (int kk = 0; kk < 4; ++kk) {
        u32x4 s4 = {pk2(S[2 * kk][0], S[2 * kk][1]), pk2(S[2 * kk][2], S[2 * kk][3]), pk2(S[2 * kk + 1][0], S[2 * kk + 1][1]), pk2(S[2 * kk + 1][2], S[2 * kk + 1][3])};
        Sbf[kk] = __builtin_bit_cast(bf16x8, s4);
      }
      __syncthreads();
      if (j + 1 < NCHUNK) { commit(); __syncthreads(); }
    }
  }
}

DI void gla_merge_phase(const Ctx& cx, const Params& p, int layer) {
  const int lane = cx.tid & 63, wg = (cx.bid * 256 + cx.tid) >> 6, nw = cx.nblk * 4;
  const u16* OF = (const u16*)(p.ws + OFF_R1); u16* OB = (u16*)(p.ws + OFF_R0); const u16* G = (const u16*)(p.ws + OFF_R4);
  const float* ng = p.gla_norm_g + (layer >> 1) * 256 + (lane & 15) * 16;
  float ngv[16];
#pragma unroll
  for (int i = 0; i < 16; ++i) ngv[i] = ng[i];
  for (int m0 = wg; m0 < MROWS; m0 += 2 * nw) {
    float o[2][16], gv[2][16];
#pragma unroll
    for (int q = 0; q < 2; ++q) {
      const int m = m0 + q * nw;
      if (m < MROWS) {
        const size_t base = (size_t)m * 1024 + lane * 16;
#pragma unroll
        for (int hlf = 0; hlf < 2; ++hlf) {
          u32x4 a = *(const u32x4*)(OF + base + hlf * 8), bq = *(const u32x4*)(OB + base + hlf * 8), c = *(const u32x4*)(G + base + hlf * 8);
#pragma unroll
          for (int e = 0; e < 4; ++e) {
            o[q][hlf * 8 + 2 * e] = bf_lo(a[e]) + bf_lo(bq[e]); o[q][hlf * 8 + 2 * e + 1] = bf_hi(a[e]) + bf_hi(bq[e]);
            gv[q][hlf * 8 + 2 * e] = bf_lo(c[e]); gv[q][hlf * 8 + 2 * e + 1] = bf_hi(c[e]);
          }
        }
      }
    }
#pragma unroll
    for (int q = 0; q < 2; ++q) {
      const int m = m0 + q * nw;
      if (m >= MROWS) continue;
      const size_t base = (size_t)m * 1024 + lane * 16;
      float ss = 0.f;
#pragma unroll
      for (int i = 0; i < 16; ++i) ss += o[q][i] * o[q][i];
      ss += __shfl_xor(ss, 1); ss += __shfl_xor(ss, 2); ss += __shfl_xor(ss, 4); ss += __shfl_xor(ss, 8);
      const float r = rsqrtf(ss * (1.f / 256.f) + 1e-6f);
      unsigned ov[8];
#pragma unroll
      for (int e = 0; e < 8; ++e) {
        float v0 = o[q][2 * e] * r * ngv[2 * e] * siluf(gv[q][2 * e]), v1 = o[q][2 * e + 1] * r * ngv[2 * e + 1] * siluf(gv[q][2 * e + 1]);
        ov[e] = pk2(v0, v1);
      }
      u32x4 w0 = {ov[0], ov[1], ov[2], ov[3]}, w1 = {ov[4], ov[5], ov[6], ov[7]};
      *(u32x4*)(OB + base) = w0; *(u32x4*)(OB + base + 8) = w1;
    }
  }
}

DI void ln_phase(const Ctx& cx, const Params& p, int layer, char* smem) {
  const int lane = cx.tid & 63, wg = (cx.bid * 256 + cx.tid) >> 6, nw = cx.nblk * 4;
  const float* mod = (const float*)(p.ws + OFF_MOD);
  const u16* Y = (const u16*)(p.ws + OFF_R2);
  u16* H = (u16*)(p.ws + OFF_R0);
  const bool last = layer == 3;
  f32x4 gg[4], bb[4];
#pragma unroll
  for (int i = 0; i < 4; ++i) { const int c = 4 * lane + 256 * i; gg[i] = *(const f32x4*)(p.ln_g + layer * 1024 + c); bb[i] = *(const f32x4*)(p.ln_b + layer * 1024 + c); }
  for (int m0 = wg; m0 < MROWS; m0 += 2 * nw) {
    float v[2][16]; f32x4 shn[2][4], scn[2][4];
    float sum[2] = {0.f, 0.f};
    bool act[2];
#pragma unroll
    for (int q = 0; q < 2; ++q) {
      const int m = m0 + q * nw;
      const int b = m / LSEQ, pos = m % LSEQ;
      act[q] = (m < MROWS) && !(last && pos < CTXL);
      if (act[q]) {
        const int cond = pos < CTXL ? 8 : b;
        const float* xr = resid_in(p, layer, b, pos);
        const float* md = mod + (size_t)(layer * 9 + cond) * 3072;
        const float* mdn = mod + (size_t)((layer + 1) * 9 + cond) * 3072;
#pragma unroll
        for (int i = 0; i < 4; ++i) {
          const int c = 4 * lane + 256 * i;
          f32x4 xv = *(const f32x4*)(xr + c), gt = *(const f32x4*)(md + 2048 + c);
          u32x2 yv = *(const u32x2*)(Y + (size_t)m * 1024 + c);
          if (!last) { shn[q][i] = *(const f32x4*)(mdn + c); scn[q][i] = *(const f32x4*)(mdn + 1024 + c); }
          v[q][4 * i + 0] = ALPHA * xv[0] + gt[0] * bf_lo(yv[0]); v[q][4 * i + 1] = ALPHA * xv[1] + gt[1] * bf_hi(yv[0]);
          v[q][4 * i + 2] = ALPHA * xv[2] + gt[2] * bf_lo(yv[1]); v[q][4 * i + 3] = ALPHA * xv[3] + gt[3] * bf_hi(yv[1]);
          sum[q] += v[q][4 * i] + v[q][4 * i + 1] + v[q][4 * i + 2] + v[q][4 * i + 3];
        }
      }
    }
#pragma unroll
    for (int q = 0; q < 2; ++q) {
      if (!act[q]) continue;
      const int m = m0 + q * nw;
      const int b = m / LSEQ, pos = m % LSEQ;
      float* xo = resid_out(p, b, pos);
      float sm = sum[q];
#pragma unroll
      for (int s2 = 1; s2 < 64; s2 <<= 1) sm += __shfl_xor(sm, s2);
      const float mu = sm * (1.f / 1024.f);
      float var = 0.f;
#pragma unroll
      for (int i = 0; i < 16; ++i) { float d = v[q][i] - mu; var += d * d; }
#pragma unroll
      for (int s2 = 1; s2 < 64; s2 <<= 1) var += __shfl_xor(var, s2);
      const float rstd = rsqrtf(var * (1.f / 1024.f) + 1e-5f);
#pragma unroll
      for (int i = 0; i < 4; ++i) {
        const int c = 4 * lane + 256 * i;
        f32x4 xn;
#pragma unroll
        for (int e = 0; e < 4; ++e) xn[e] = (v[q][4 * i + e] - mu) * rstd * gg[i][e] + bb[i][e];
        *(f32x4*)(xo + c) = xn;
        if (!last) {
          f32x4 hh = xn * (scn[q][i] + 1.f) + shn[q][i];
          u32x2 o = {pk2(hh[0], hh[1]), pk2(hh[2], hh[3])};
          *(u32x2*)(H + (size_t)m * 1024 + c) = o;
        }
      }
    }
  }
  if (!last) {
    const int nconv = convert_items(layer + 1);
    for (int it = cx.bid; it < nconv; it += cx.nblk) convert_item(cx, p, layer + 1, it, smem);
  }
}

DI void na_attn_phase(const Ctx& cx, const Params& p, int layer, char* smem) {
  const int tid = cx.tid, lane = tid & 63, w = tid >> 6, l15 = lane & 15, g = lane >> 4;
  const bool need_ctx = layer < 3;
  const int RPI = need_ctx ? 18 : 16;
  const u16* Q = (const u16*)(p.ws + OFF_R1); const u16* K = (const u16*)(p.ws + OFF_R2); const u16* VT = (const u16*)(p.ws + OFF_R3);
  const u16* G = (const u16*)(p.ws + OFF_R4); u16* MG = (u16*)(p.ws + OFF_R0);
  float* rpbS = (float*)(smem + 65536 + 64);
  const char* Qs = smem + 32768;
  const int sw7 = (l15 >> 1) & 7;
  const int nitems = NB * 16 * RPI;
  const int ws = w == 0 ? 0 : (w == 1 ? 8 : (w == 2 ? 24 : 32));
  const int qc = 16 * w + l15;
  const int cs = min(max(qc - 8, 0), 48);
  const int d0 = ws + 4 * g - cs;
  const int bi0 = ws + 4 * g - qc + 15;
  const int kls = ((ws + l15) >> 1) & 7;
  const int kL0 = (ws + l15) * 128 + ((g ^ kls) << 4), kL1 = (ws + l15) * 128 + (((4 + g) ^ kls) << 4);
  const int kC0 = l15 * 128 + ((g ^ sw7) << 4), kC1 = l15 * 128 + (((4 + g) ^ sw7) << 4);
  const int vL0 = l15 * 128 + ((((ws >> 3) + (g >> 1)) ^ sw7) << 4) + (g & 1) * 8, vL1 = l15 * 128 + ((((ws >> 3) + 2 + (g >> 1)) ^ sw7) << 4) + (g & 1) * 8;
  const int vC0 = l15 * 128 + (((g >> 1) ^ sw7) << 4) + (g & 1) * 8, vC1 = l15 * 128 + (((2 + (g >> 1)) ^ sw7) << 4) + (g & 1) * 8;
  const int vC2 = l15 * 128 + (((4 + (g >> 1)) ^ sw7) << 4) + (g & 1) * 8, vC3 = l15 * 128 + (((6 + (g >> 1)) ^ sw7) << 4) + (g & 1) * 8;
  for (int it = cx.bid; it < nitems; it += cx.nblk) {
    const int nlat = NB * 16 * 16;
    const int rg = it < nlat ? (it & 15) : 16 + ((it - nlat) & 1), bh = it < nlat ? (it >> 4) : ((it - nlat) >> 1), h = bh & 15, b = bh >> 4;
    const bool lat = rg < 16;
    const int r0 = rg * 2;
    const int ylo = lat ? min(max(r0 - 4, 0), 24) : 0;
    const int yhi = lat ? min(max(r0 + 1 - 4, 0), 24) + 7 : -1;
    const int nloc = yhi - ylo + 1;
    const int nst = nloc + 4;
    const int mbase = b * LSEQ + (lat ? CTXL + r0 * 64 : (rg - 16) * 128);
    __syncthreads();
    for (int i = tid; i < 465; i += 256) rpbS[i] = p.na_rpb[((size_t)(layer >> 1) * 16 + h) * 465 + i] * 1.4426950408889634f;
#pragma unroll
    for (int i = 0; i < 4; ++i) {
      const int c = tid + 256 * i, qrow = c >> 3, ch = c & 7;
      u32x4 v = *(const u32x4*)(Q + (unsigned)((mbase + qrow) * 1024 + h * 64 + ch * 8));
      *(u32x4*)(smem + 32768 + qrow * 128 + ((ch ^ ((qrow >> 1) & 7)) << 4)) = v;
    }
    auto issue = [&](int st, int buf) {
      const int p0 = st < nloc ? CTXL + (ylo + st) * 64 : (st - nloc) * 64;
#pragma unroll
      for (int i = 0; i < 2; ++i) {
        const int row = w * 16 + i * 8 + (lane >> 3), ch = (lane & 7) ^ ((row >> 1) & 7);
        __builtin_amdgcn_global_load_lds((const unsigned*)(K + (unsigned)((b * LSEQ + p0 + row) * 1024 + h * 64 + ch * 8)), (unsigned*)(smem + buf * 16384 + w * 2048 + i * 1024 + lane * 16), 16, 0, 0);
        const int r32 = row & 31, vrow = (row & ~31) + 8 * ((r32 & 15) >> 2) + 4 * (r32 >> 4) + (r32 & 3);
        __builtin_amdgcn_global_load_lds((const unsigned*)(VT + (unsigned)((b * 1024 + h * 64 + vrow) * LSEQ + p0 + ch * 8)), (unsigned*)(smem + buf * 16384 + 8192 + w * 2048 + i * 1024 + lane * 16), 16, 0, 0);
      }
    };
    issue(0, 0);
    __syncthreads();
    float mrun[2], lrun[2];
    f32x4 o[2][4];
#pragma unroll
    for (int rr = 0; rr < 2; ++rr) {
      mrun[rr] = -1e20f; lrun[rr] = 0.f;
#pragma unroll
      for (int dt = 0; dt < 4; ++dt) o[rr][dt] = (f32x4){0.f, 0.f, 0.f, 0.f};
    }
    auto block = [&](const char* Ks, const char* Vs, int k0off, int k1off, int v0off, int v1off, bool local, int y, int ist, int ibuf) {
#pragma unroll
      for (int pr = 0; pr < 1; ++pr) {
        bf16x8 kf[2][2];
#pragma unroll
        for (int kt = 0; kt < 2; ++kt) { kf[kt][0] = *(const bf16x8*)(Ks + k0off + kt * 2048); kf[kt][1] = *(const bf16x8*)(Ks + k1off + kt * 2048); }
        if (ist >= 0) issue(ist, ibuf);
        f32x4 sc[2][2];
#pragma unroll
        for (int q2 = 0; q2 < 2; ++q2) {
          const int rr = 2 * pr + q2;
          const bf16x8 qf0 = *(const bf16x8*)(Qs + rr * 8192 + w * 2048 + kC0), qf1 = *(const bf16x8*)(Qs + rr * 8192 + w * 2048 + kC1);
          const int r = r0 + rr;
          const int rs = min(max(r - 4, 0), 24);
          const bool active = (y >= rs) && (y < rs + 8);
          float bv[8];
          if (local) {
            const float* bp = rpbS + ((y - r + 7) * 31 + bi0);
#pragma unroll
            for (int kt = 0; kt < 2; ++kt)
#pragma unroll
              for (int jj = 0; jj < 4; ++jj) bv[kt * 4 + jj] = bp[16 * kt + jj];
            asm volatile("" : "+v"(bv[0]), "+v"(bv[1]), "+v"(bv[2]), "+v"(bv[3]), "+v"(bv[4]), "+v"(bv[5]), "+v"(bv[6]), "+v"(bv[7]));
          }
#pragma unroll
          for (int kt = 0; kt < 2; ++kt) {
            sc[q2][kt] = mfma16(kf[kt][0], qf0, (f32x4){0.f, 0.f, 0.f, 0.f});
            sc[q2][kt] = mfma16(kf[kt][1], qf1, sc[q2][kt]);
          }
          if (local) {
#pragma unroll
            for (int kt = 0; kt < 2; ++kt)
#pragma unroll
              for (int jj = 0; jj < 4; ++jj) {
                const bool valid = active && ((unsigned)(d0 + 16 * kt + jj) < 16u);
                sc[q2][kt][jj] = valid ? sc[q2][kt][jj] + bv[kt * 4 + jj] : -1e30f;
              }
          }
        }
        float mx[2];
        bool need = false;
#pragma unroll
        for (int q2 = 0; q2 < 2; ++q2) {
          float m = fmaxf(fmaxf(fmaxf(sc[q2][0][0], sc[q2][0][1]), fmaxf(sc[q2][0][2], sc[q2][0][3])), fmaxf(fmaxf(sc[q2][1][0], sc[q2][1][1]), fmaxf(sc[q2][1][2], sc[q2][1][3])));
          mx[q2] = m; need = need || (m > mrun[2 * pr + q2] + 8.f);
        }
        if (__builtin_amdgcn_ballot_w64(need) != 0ull) {
#pragma unroll
          for (int q2 = 0; q2 < 2; ++q2) {
            const int rr = 2 * pr + q2;
            float m = mx[q2];
            m = fmaxf(m, __shfl_xor(m, 16)); m = fmaxf(m, __shfl_xor(m, 32));
            const float mnew = fmaxf(mrun[rr], m);
            const float alpha = __builtin_amdgcn_exp2f(mrun[rr] - mnew);
            mrun[rr] = mnew; lrun[rr] *= alpha;
#pragma unroll
            for (int dt = 0; dt < 4; ++dt) o[rr][dt] *= alpha;
          }
        }
        bf16x8 pfrag[2];
#pragma unroll
        for (int q2 = 0; q2 < 2; ++q2) {
          const int rr = 2 * pr + q2;
          const float mcur = mrun[rr];
          float ps = 0.f;
#pragma unroll
          for (int kt = 0; kt < 2; ++kt)
#pragma unroll
            for (int jj = 0; jj < 4; ++jj) { float e = __builtin_amdgcn_exp2f(sc[q2][kt][jj] - mcur); sc[q2][kt][jj] = e; ps += e; }
          lrun[rr] += ps;
          u32x4 p4 = {pk2(sc[q2][0][0], sc[q2][0][1]), pk2(sc[q2][0][2], sc[q2][0][3]), pk2(sc[q2][1][0], sc[q2][1][1]), pk2(sc[q2][1][2], sc[q2][1][3])};
          pfrag[q2] = __builtin_bit_cast(bf16x8, p4);
        }
#pragma unroll
        for (int dt = 0; dt < 4; ++dt) {
          u32x2 lo = *(const u32x2*)(Vs + v0off + dt * 2048);
          u32x2 hi = *(const u32x2*)(Vs + v1off + dt * 2048);
          u32x4 v4 = {lo[0], lo[1], hi[0], hi[1]};
          const bf16x8 vf = __builtin_bit_cast(bf16x8, v4);
#pragma unroll
          for (int q2 = 0; q2 < 2; ++q2) o[2 * pr + q2][dt] = mfma16(vf, pfrag[q2], o[2 * pr + q2][dt]);
        }
        __builtin_amdgcn_sched_barrier(0);
      }
    };
    for (int st = 0; st < nst; ++st) {
      const int buf = st & 1;
      const char* Ks = smem + buf * 16384; const char* Vs = Ks + 8192;
      const int ist = st + 1 < nst ? st + 1 : -1;
      if (st < nloc) {
        block(Ks, Vs, kL0, kL1, vL0, vL1, true, ylo + st, ist, buf ^ 1);
      } else {
        block(Ks, Vs, kC0, kC1, vC0, vC1, false, 0, ist, buf ^ 1);
        __builtin_amdgcn_sched_barrier(0);
        block(Ks, Vs, kC0 + 4096, kC1 + 4096, vC2, vC3, false, 0, -1, 0);
      }
      __syncthreads();
    }
#pragma unroll
    for (int rr = 0; rr < 2; ++rr) {
      float l = lrun[rr];
      l += __shfl_xor(l, 16); l += __shfl_xor(l, 32);
      const float inv = __builtin_amdgcn_rcpf(l);
#pragma unroll
      for (int dp = 0; dp < 2; ++dp) {
        const unsigned a = (unsigned)((mbase + rr * 64 + 16 * w + l15) * 1024 + h * 64 + dp * 32 + 8 * g);
        u32x4 gv = *(const u32x4*)(G + a);
        const f32x4 oa = o[rr][2 * dp] * inv, ob = o[rr][2 * dp + 1] * inv;
        u32x4 ov = {pk2(oa[0] * siluf(bf_lo(gv[0])), oa[1] * siluf(bf_hi(gv[0]))), pk2(oa[2] * siluf(bf_lo(gv[1])), oa[3] * siluf(bf_hi(gv[1]))),
                    pk2(ob[0] * siluf(bf_lo(gv[2])), ob[1] * siluf(bf_hi(gv[2]))), pk2(ob[2] * siluf(bf_lo(gv[3])), ob[3] * siluf(bf_hi(gv[3])))};
        *(u32x4*)(MG + a) = ov;
      }
    }
  }
}

#define XB_TMO      128
#define XB_XCNT(j)  (256  + 64 * (j))
#define XB_XSUB(j)  (1280 + 64 * (j))
#define XB_XGEN(j)  (2304 + 64 * (j))
#define XB_TOP      3328
#define XB_TOPGEN   3392
#define XCD_BAR_WORDS 3456
#define XB_SPIN_CAP (1u << 22)
#define LAS __attribute__((address_space(3)))
DI unsigned xb_ld(unsigned* p)              { return __hip_atomic_load(p, __ATOMIC_RELAXED, __HIP_MEMORY_SCOPE_AGENT); }
DI unsigned xb_add(unsigned* p, unsigned v) { return __hip_atomic_fetch_add(p, v, __ATOMIC_RELAXED, __HIP_MEMORY_SCOPE_AGENT); }
DI unsigned xb_xcc_id() { return (unsigned)__builtin_amdgcn_s_getreg((3 << 11) | 20) & 0xFu; }
#define XB_SPIN(cond, bar) do { unsigned _sp = 0; while (cond) { __builtin_amdgcn_s_sleep(1); \
    if ((++_sp & 255u) == 0u) { if (xb_ld(&(bar)[XB_TMO])) break; if (_sp > XB_SPIN_CAP) { atomicAdd(&(bar)[XB_TMO], 1u); break; } } } } while (0)
struct XcdBarrier { unsigned* bar; unsigned x; volatile LAS unsigned* st; };
DI XcdBarrier xcd_barrier_post(unsigned* bar, volatile LAS unsigned* st) {
  XcdBarrier b; b.bar = bar; b.x = xb_xcc_id(); b.st = st;
  if (threadIdx.x == 0) (void)xb_add(&bar[XB_XCNT(b.x)], 1u);
  return b;
}
DI void xcd_barrier_complete(unsigned* bar, unsigned x, unsigned& nloc, unsigned& nx) {
  const unsigned G = gridDim.x * gridDim.y * gridDim.z;
  unsigned sum, cnt, mine, sp = 0u;
  for (;;) {
    sum = 0u; cnt = 0u; mine = 0u;
#pragma unroll
    for (unsigned j = 0; j < 16; ++j) { const unsigned c = xb_ld(&bar[XB_XCNT(j)]); sum += c; cnt += (c > 0u) ? 1u : 0u; mine = (j == x) ? c : mine; }
    if (sum == G) break;
    __builtin_amdgcn_s_sleep(1);
    if ((++sp & 255u) == 0u) { if (xb_ld(&bar[XB_TMO])) break; if (sp > XB_SPIN_CAP) { atomicAdd(&bar[XB_TMO], 1u); break; } }
  }
  nloc = mine > 0u ? mine : 1u; nx = cnt > 0u ? cnt : 1u;
}
DI void xcd_barrier(const XcdBarrier& b) {
  asm volatile("s_waitcnt vmcnt(0)" ::: "memory");
  __syncthreads();
  if (threadIdx.x == 0) {
    unsigned* bar = b.bar;
    __builtin_amdgcn_s_waitcnt(0);
    unsigned nloc = b.st[0], nx = b.st[1];
    if (nloc == 0u) { xcd_barrier_complete(bar, b.x, nloc, nx); b.st[0] = nloc; b.st[1] = nx; }
    const unsigned old = xb_add(&bar[XB_XSUB(b.x)], 1u);
    const unsigned gen = old / nloc;
    if (old + 1u == (gen + 1u) * nloc) {
      __builtin_amdgcn_fence(__ATOMIC_RELEASE, "agent");
      asm volatile("s_waitcnt vmcnt(0)" ::: "memory");
      const unsigned og = xb_add(&bar[XB_TOP], 1u);
      const unsigned tg = og / nx;
      if (og + 1u == (tg + 1u) * nx) xb_add(&bar[XB_TOPGEN], 1u);
      else XB_SPIN(xb_ld(&bar[XB_TOPGEN]) == tg, bar);
      __builtin_amdgcn_fence(__ATOMIC_ACQUIRE, "agent");
      xb_add(&bar[XB_XGEN(b.x)], 1u);
      asm volatile("s_waitcnt vmcnt(0)" ::: "memory");
    } else {
      XB_SPIN(xb_ld(&bar[XB_XGEN(b.x)]) == gen, bar);
      __builtin_amdgcn_fence(__ATOMIC_ACQUIRE, "agent");
      asm volatile("s_waitcnt vmcnt(0)" ::: "memory");
    }
  }
  __syncthreads();
}

constexpr int NPHASES = 22;
constexpr int SMEM_BYTES = 79872;
__global__ void __launch_bounds__(256, 2) fwd_megakernel(Params p) {
  __shared__ __attribute__((aligned(16))) char smem[SMEM_BYTES];
  cg::grid_group grid = cg::this_grid();
  __shared__ uint4 xb_words;
  if (threadIdx.x == 0) xb_words = make_uint4(0u, 0u, 0u, 0u);
  __syncthreads();
  XcdBarrier xb = xcd_barrier_post((unsigned*)(p.ws + OFF_BAR), (volatile LAS unsigned*)&xb_words);
  const int wave_id = __builtin_amdgcn_readfirstlane((int)(threadIdx.x >> 6));
  for (int ph = p.ph_lo; ph < p.ph_hi; ++ph) {
    Ctx cx; cx.tid = wave_id * 64 + (int)__builtin_amdgcn_mbcnt_hi(~0u, __builtin_amdgcn_mbcnt_lo(~0u, 0u)); cx.bid = blockIdx.x; cx.nblk = gridDim.x;
    asm volatile("" : "+v"(cx.tid)); asm volatile("" : "+s"(cx.bid)); asm volatile("" : "+s"(cx.nblk));
    Params pp = p;
    asm volatile("" : "+s"(pp.ws)); asm volatile("" : "+s"(pp.out));
    if (ph == 0) phase0a(cx, pp, smem);
    else if (ph == 1) phase0b(cx, pp);
    else {
      const int q = ph - 2, pair = q / 10, r = q % 10;
      const int layer = 2 * pair + (r >= 6 ? 1 : 0);
      int gk = -1;
      if (r == 0) gk = 0; else if (r == 6) gk = 1; else if (r == 4 || r == 8) gk = 2;
      asm volatile("" : "+s"(gk));
      if (gk >= 0) { for (int rep = 0; rep < (gk == 2 ? REP_GOUT : REP_GIN); ++rep) gemm_phase(cx, pp, gk, layer, smem); }
      else if (r == 5 || r == 9) ln_phase(cx, pp, layer, smem);
      else if (r == 1) { for (int rep = 0; rep < REP_PREP; ++rep) gla_prep_phase(cx, pp, layer, smem); }
      else if (r == 2) { for (int rep = 0; rep < REP_CHAIN; ++rep) gla_chain_phase(cx, pp, smem); }
      else if (r == 3) gla_merge_phase(cx, pp, layer);
      else { for (int rep = 0; rep < REP_NA; ++rep) na_attn_phase(cx, pp, layer, smem); }
    }
    if (ph + 1 < p.ph_hi) { if (p.ph_hi > NPHASES) grid.sync(); else xcd_barrier(xb); }
  }
}

extern "C" void kernel_launch(void* const* d_in, const int* in_sizes, int n_in, void* d_out, int out_size, void* d_ws, size_t ws_size, hipStream_t stream) {
  static int grid_blocks = 0;
  if (!grid_blocks) {
    int dev = 0, cus = 0, per_cu = 0;
    hipGetDevice(&dev);
    hipDeviceGetAttribute(&cus, hipDeviceAttributeMultiprocessorCount, dev);
    hipOccupancyMaxActiveBlocksPerMultiprocessor(&per_cu, fwd_megakernel, 256, 0);
    if (per_cu > 2) per_cu = 2;
    grid_blocks = cus * per_cu;
    if (grid_blocks <= 0 || (grid_blocks & 7)) grid_blocks = -1;
  }
  if (grid_blocks < 0 || ws_size < WS_END || n_in < 16) return;
  Params p{};
  p.x = (const float*)d_in[0]; p.c = (const float*)d_in[1]; p.ctx = (const float*)d_in[2]; p.c_ctx = (const float*)d_in[3];
  p.ada_w = (const float*)d_in[4]; p.ada_b = (const float*)d_in[5]; p.ln_g = (const float*)d_in[6]; p.ln_b = (const float*)d_in[7];
  p.w_out = (const float*)d_in[8]; p.gla_w_in = (const float*)d_in[9]; p.gla_dec_w1 = (const float*)d_in[10]; p.gla_dec_w2 = (const float*)d_in[11];
  p.gla_dec_b = (const float*)d_in[12]; p.gla_norm_g = (const float*)d_in[13]; p.na_w_in = (const float*)d_in[14]; p.na_rpb = (const float*)d_in[15];
  p.out = (float*)d_out; p.ws = (unsigned char*)d_ws;
#if MULTI_LAUNCH
  for (int ph = 0; ph < NPHASES; ++ph) {
    p.ph_lo = ph; p.ph_hi = ph + 1;
    hipLaunchKernelGGL(fwd_megakernel, dim3(grid_blocks), dim3(256), 0, stream, p);
  }
#else
  p.ph_lo = 0; p.ph_hi = NPHASES;
  hipMemsetAsync((char*)d_ws + OFF_BAR, 0, 3456 * 4, stream);
  void* args[] = {&p};
  hipLaunchCooperativeKernel((void*)fwd_megakernel, dim3(grid_blocks), dim3(256), args, 0, stream);
#endif
}
```
